# Optimizing an MI355X kernel written in HIP

```python
import numpy as np
import jax, jax.numpy as jnp
from jax import lax

D_MODEL = 1024
BATCH = 8
SEQ = 4096
DEPTH = 1

NSA_HEADS = 8
NSA_GROUPS = 2
NSA_HPG = NSA_HEADS // NSA_GROUPS
NSA_DH = 64
CMP_STRIDE = 16
CMP_LEN = 2 * CMP_STRIDE
CMP_HIDDEN = 128
SEL_BLOCK = 64
SEL_TOPK = 16
WINDOW = 512
NSA_QBLOCK = 64
FORCE_BONUS = 1e4
RET_HEADS = 8
RET_DK = 64
RET_DV = 64
RET_CHUNK = 128
ROPE_BASE = 10000.0
D_FF = 2816
EPS = 1e-6
NEG = -1e30

NSA_QW = NSA_HEADS * NSA_DH
NSA_KVW = NSA_GROUPS * NSA_DH
RET_QW = RET_HEADS * RET_DK
RET_VW = RET_HEADS * RET_DV
IN_WIDTHS = [NSA_QW, NSA_KVW, NSA_KVW, NSA_KVW, NSA_KVW, NSA_KVW, NSA_KVW, 3 * NSA_HEADS,
             RET_QW, RET_QW, RET_VW, RET_VW, D_MODEL, D_MODEL]
IN_W = sum(IN_WIDTHS)

kernel_name = "hybrid_nsa_retention_macaron_adaln"


def rmsnorm(x, w):
    xf = x.astype(jnp.float32)
    y = xf * lax.rsqrt(jnp.mean(xf * xf, axis=-1, keepdims=True) + EPS)
    return (y * w.astype(jnp.float32)).astype(x.dtype)


def modulate(h, shift, scale):
    return h * (1 + scale[:, None, :]) + shift[:, None, :]


def swiglu(h, w_in, w_out):
    a, b = jnp.split(h @ w_in, 2, axis=-1)
    return (jax.nn.silu(a) * b) @ w_out


def masked_softmax(s, mask):
    return jax.nn.softmax(jnp.where(mask, s.astype(jnp.float32), NEG), axis=-1)


def rope(x, pos):
    half = x.shape[-1] // 2
    inv = ROPE_BASE ** (-jnp.arange(half, dtype=jnp.float32) / half)
    ang = pos.astype(jnp.float32)[:, None] * inv[None, :]
    cos = jnp.cos(ang)[None, :, None, :]
    sin = jnp.sin(ang)[None, :, None, :]
    x1 = x[..., :half].astype(jnp.float32)
    x2 = x[..., half:].astype(jnp.float32)
    return jnp.concatenate([x1 * cos - x2 * sin, x1 * sin + x2 * cos], axis=-1).astype(x.dtype)


def compress(raw, pe, w1, w2):
    B, S, G, dh = raw.shape
    ch = raw.reshape(B, S // CMP_STRIDE, CMP_STRIDE, G, dh)
    blocks = jnp.concatenate([ch[:, :-1], ch[:, 1:]], axis=2)
    blocks = blocks + pe[None, None, :, None, :]
    nc = blocks.shape[1]
    flat = blocks.transpose(0, 1, 3, 2, 4).reshape(B, nc, G, CMP_LEN * dh)
    return jax.nn.silu(flat @ w1) @ w2


def nsa_attention(q, k_cmp, v_cmp, k_slc, v_slc, k_win, v_win, gates,
                  cmp_k_pe, cmp_k_w1, cmp_k_w2, cmp_v_pe, cmp_v_w1, cmp_v_w2):
    B, S = q.shape[:2]
    G, HPG, dh, QB = NSA_GROUPS, NSA_HPG, NSA_DH, NSA_QBLOCK
    kc = compress(k_cmp, cmp_k_pe, cmp_k_w1, cmp_k_w2)
    vc = compress(v_cmp, cmp_v_pe, cmp_v_w1, cmp_v_w2)
    nc = kc.shape[1]
    ns = S // SEL_BLOCK
    n_sel = min(SEL_TOPK, ns)
    cmp_end = jnp.arange(nc) * CMP_STRIDE + CMP_LEN - 1
    c_start = np.arange(nc) * CMP_STRIDE
    s_start = np.arange(ns) * SEL_BLOCK
    overlap = jnp.asarray((c_start[:, None] < s_start[None, :] + SEL_BLOCK) &
                          (c_start[:, None] + CMP_LEN > s_start[None, :]), dtype=jnp.float32)
    ks_blk = k_slc.reshape(B, ns, SEL_BLOCK, G, dh).transpose(0, 3, 1, 2, 4)
    vs_blk = v_slc.reshape(B, ns, SEL_BLOCK, G, dh).transpose(0, 3, 1, 2, 4)
    kw_pad = jnp.pad(k_win, ((0, 0), (WINDOW, 0), (0, 0), (0, 0)))
    vw_pad = jnp.pad(v_win, ((0, 0), (WINDOW, 0), (0, 0), (0, 0)))
    scale = NSA_DH ** -0.5
    b_ix = jnp.arange(B)[:, None, None, None]
    g_ix = jnp.arange(G)[None, :, None, None]
    j_blk = jnp.arange(ns)
    sel_off = jnp.arange(SEL_BLOCK)

    def block(nb):
        q0 = nb * QB
        t = q0 + jnp.arange(QB)
        qb = lax.dynamic_slice_in_dim(q, q0, QB, axis=1).reshape(B, QB, G, HPG, dh) * scale
        m_c = cmp_end[None, :] <= t[:, None]
        p_c = masked_softmax(jnp.einsum('bqghd,bngd->bghqn', qb, kc), m_c)
        p_c = p_c * jnp.any(m_c, axis=-1)[:, None].astype(jnp.float32)
        o_cmp = jnp.einsum('bghqn,bngd->bqghd', p_c, vc)
        imp = jnp.einsum('bghqn,nj->bgqj', p_c, overlap)
        cur = t // SEL_BLOCK
        forced = (j_blk[None, :] == 0) | (j_blk[None, :] == cur[:, None]) | (j_blk[None, :] == cur[:, None] - 1)
        valid = j_blk[None, :] * SEL_BLOCK <= t[:, None]
        imp = jnp.where(forced, imp + FORCE_BONUS, imp)
        imp = jnp.where(valid, imp, -FORCE_BONUS)
        _, idx = lax.top_k(imp, n_sel)
        kg = ks_blk[b_ix, g_ix, idx]
        vg = vs_blk[b_ix, g_ix, idx]
        kpos = idx[..., None] * SEL_BLOCK + sel_off
        m_s = (kpos <= t[None, None, :, None, None])[:, :, None]
        s_s = jnp.einsum('bqghd,bgqnld->bghqnl', qb, kg)
        s_s = jnp.where(m_s, s_s.astype(jnp.float32), NEG).reshape(B, G, HPG, QB, n_sel * SEL_BLOCK)
        p_s = jax.nn.softmax(s_s, axis=-1).reshape(B, G, HPG, QB, n_sel, SEL_BLOCK)
        o_slc = jnp.einsum('bghqnl,bgqnld->bqghd', p_s, vg)
        kw = lax.dynamic_slice_in_dim(kw_pad, q0, WINDOW + QB, axis=1)
        vw = lax.dynamic_slice_in_dim(vw_pad, q0, WINDOW + QB, axis=1)
        wpos = q0 - WINDOW + jnp.arange(WINDOW + QB)
        m_w = (wpos[None, :] <= t[:, None]) & (wpos[None, :] > t[:, None] - WINDOW) & (wpos[None, :] >= 0)
        p_w = masked_softmax(jnp.einsum('bqghd,bkgd->bghqk', qb, kw), m_w)
        o_win = jnp.einsum('bghqk,bkgd->bqghd', p_w, vw)
        g = lax.dynamic_slice_in_dim(gates, q0, QB, axis=1).reshape(B, QB, G, HPG, 3).astype(jnp.float32)
        o = g[..., 0:1] * o_cmp + g[..., 1:2] * o_slc + g[..., 2:3] * o_win
        return o.reshape(B, QB, G * HPG * dh).astype(q.dtype)

    out = lax.map(block, jnp.arange(S // QB))
    return out.transpose(1, 0, 2, 3).reshape(B, S, NSA_QW)


def retention(q, k, v, pos):
    B, S, H, dk = q.shape
    dv = v.shape[-1]
    C = RET_CHUNK
    n_chunk = S // C
    q = rope(q, pos)
    k = rope(k, pos) * (dk ** -0.5)
    log_g = jnp.log(1.0 - 2.0 ** (-5.0 - jnp.arange(H, dtype=jnp.float32)))
    i = jnp.arange(C, dtype=jnp.float32)
    diff = i[:, None] - i[None, :]
    decay_mat = jnp.where(diff >= 0, jnp.exp(log_g[:, None, None] * jnp.maximum(diff, 0.0)), 0.0)
    q_decay = jnp.exp(log_g[:, None] * (i + 1.0))[..., None]
    k_decay = jnp.exp(log_g[:, None] * (C - 1.0 - i))[..., None]
    chunk_decay = jnp.exp(log_g * C)[:, None, None]
    qc = q.reshape(B, n_chunk, C, H, dk).transpose(1, 0, 3, 2, 4)
    kc = k.reshape(B, n_chunk, C, H, dk).transpose(1, 0, 3, 2, 4)
    vc = v.reshape(B, n_chunk, C, H, dv).transpose(1, 0, 3, 2, 4)

    def step(state, inp):
        qi, ki, vi = inp
        inner = jnp.einsum('bhid,bhjd->bhij', qi, ki) * decay_mat
        o = jnp.einsum('bhij,bhjv->bhiv', inner, vi) + jnp.einsum('bhid,bhdv->bhiv', qi, state) * q_decay
        state = state * chunk_decay + jnp.einsum('bhjd,bhjv->bhdv', ki * k_decay, vi)
        return state, o

    state0 = jnp.zeros((B, H, dk, dv), jnp.float32)
    _, o = lax.scan(step, state0, (qc, kc, vc))
    return o.transpose(1, 0, 3, 2, 4).reshape(B, S, H, dv)


def setup_inputs(seed: int = 0) -> dict:
    key = jax.random.key(seed)
    ks = jax.random.split(key, 26)
    f32 = jnp.float32
    L, D = DEPTH, D_MODEL

    def nrm(k, shape, s):
        return jax.random.normal(k, shape, f32) * s

    return {
        "x": nrm(ks[0], (BATCH, SEQ, D), 1.0),
        "c": nrm(ks[1], (BATCH, D), 1.0),
        "ada_w": nrm(ks[2], (L, D, 9 * D), D ** -0.5),
        "ada_b": nrm(ks[3], (L, 9 * D), 0.01),
        "norm1_w": 1.0 + nrm(ks[4], (L, D), 0.02),
        "ffn1_w_in": nrm(ks[5], (L, D, 2 * D_FF), D ** -0.5),
        "ffn1_w_out": nrm(ks[6], (L, D_FF, D), D_FF ** -0.5),
        "norm2_w": 1.0 + nrm(ks[7], (L, D), 0.02),
        "w_in": nrm(ks[8], (L, D, IN_W), D ** -0.5),
        "cmp_k_pe": nrm(ks[9], (L, CMP_LEN, NSA_DH), 0.1),
        "cmp_k_w1": nrm(ks[10], (L, CMP_LEN * NSA_DH, CMP_HIDDEN), (CMP_LEN * NSA_DH) ** -0.5),
        "cmp_k_w2": nrm(ks[11], (L, CMP_HIDDEN, NSA_DH), CMP_HIDDEN ** -0.5),
        "cmp_v_pe": nrm(ks[12], (L, CMP_LEN, NSA_DH), 0.1),
        "cmp_v_w1": nrm(ks[13], (L, CMP_LEN * NSA_DH, CMP_HIDDEN), (CMP_LEN * NSA_DH) ** -0.5),
        "cmp_v_w2": nrm(ks[14], (L, CMP_HIDDEN, NSA_DH), CMP_HIDDEN ** -0.5),
        "ret_norm_w": 1.0 + nrm(ks[15], (L, RET_VW), 0.02),
        "w_nsa_up": nrm(ks[16], (L, NSA_QW, D), NSA_QW ** -0.5),
        "w_ret_up": nrm(ks[17], (L, RET_VW, D), RET_VW ** -0.5),
        "w_out": nrm(ks[18], (L, D, D), D ** -0.5),
        "norm3_w": 1.0 + nrm(ks[19], (L, D), 0.02),
        "ffn2_w_in": nrm(ks[20], (L, D, 2 * D_FF), D ** -0.5),
        "ffn2_w_out": nrm(ks[21], (L, D_FF, D), D_FF ** -0.5),
        "final_norm_w": 1.0 + nrm(ks[22], (D,), 0.02),
    }


def reference(x, c, ada_w, ada_b, norm1_w, ffn1_w_in, ffn1_w_out, norm2_w, w_in,
              cmp_k_pe, cmp_k_w1, cmp_k_w2, cmp_v_pe, cmp_v_w1, cmp_v_w2, ret_norm_w,
              w_nsa_up, w_ret_up, w_out, norm3_w, ffn2_w_in, ffn2_w_out, final_norm_w):
    B, S, D = x.shape
    pos = jnp.arange(S)
    split_pts = np.cumsum(IN_WIDTHS)[:-1].tolist()
    h = x
    for l in range(DEPTH):
        mod = jax.nn.silu(c) @ ada_w[l] + ada_b[l]
        sh1, sc1, gt1, sh2, sc2, gt2, sh3, sc3, gt3 = jnp.split(mod, 9, axis=-1)
        u = modulate(rmsnorm(h, norm1_w[l]), sh1, sc1)
        h = h + 0.5 * gt1[:, None, :] * swiglu(u, ffn1_w_in[l], ffn1_w_out[l])
        u = modulate(rmsnorm(h, norm2_w[l]), sh2, sc2)
        proj = u @ w_in[l]
        (nq, nkc, nvc, nks, nvs, nkw, nvw, ngt, rq, rk, rv, rg, ga, gb) = jnp.split(proj, split_pts, axis=-1)
        g4 = lambda a: a.reshape(B, S, NSA_GROUPS, NSA_DH)
        o_nsa = nsa_attention(nq.reshape(B, S, NSA_HEADS, NSA_DH), g4(nkc), g4(nvc), g4(nks), g4(nvs),
                              g4(nkw), g4(nvw), jax.nn.sigmoid(ngt).reshape(B, S, NSA_HEADS, 3),
                              cmp_k_pe[l], cmp_k_w1[l], cmp_k_w2[l], cmp_v_pe[l], cmp_v_w1[l], cmp_v_w2[l])
        o_ret = retention(rq.reshape(B, S, RET_HEADS, RET_DK), rk.reshape(B, S, RET_HEADS, RET_DK),
                          rv.reshape(B, S, RET_HEADS, RET_DV), pos)
        mu = jnp.mean(o_ret, axis=-1, keepdims=True)
        var = jnp.mean(jnp.square(o_ret - mu), axis=-1, keepdims=True)
        o_ret = ((o_ret - mu) * lax.rsqrt(var + EPS)).reshape(B, S, RET_VW) * ret_norm_w[l].astype(jnp.float32)
        o_ret = (o_ret * jax.nn.silu(rg.astype(jnp.float32))).astype(x.dtype)
        y_nsa = o_nsa @ w_nsa_up[l]
        y_ret = o_ret @ w_ret_up[l]
        mixed = jax.nn.sigmoid(ga) * y_nsa + jax.nn.sigmoid(gb) * y_ret
        h = h + gt2[:, None, :] * (mixed @ w_out[l])
        u = modulate(rmsnorm(h, norm3_w[l]), sh3, sc3)
        h = h + 0.5 * gt3[:, None, :] * swiglu(u, ffn2_w_in[l], ffn2_w_out[l])
    return rmsnorm(h, final_norm_w)
```

```cpp
#include <hip/hip_runtime.h>
#include <cstdio>
#include <cstdint>
namespace pg8 {
#define PG8_LAS __attribute__((address_space(3)))
typedef unsigned short bf16_t;
typedef short bf16x8 __attribute__((ext_vector_type(8)));
typedef float f32x4 __attribute__((ext_vector_type(4)));
typedef unsigned u32x4 __attribute__((ext_vector_type(4)));
typedef int v4i_t __attribute__((ext_vector_type(4)));
constexpr int BM = 256, BK = 64, HALF = 128, HTB = HALF * BK * 2  , STAGE_BYTES = 8 * HTB, NXCD = 8, WGM = 4;

__host__ __device__ __forceinline__ int lds_byte(int r, int c) { const int st = (r >> 4) * 2 + (c >> 5), rr = r & 15, cc = c & 31, ob = rr * 64 + cc * 2; return st * 1024 + (ob ^ (((ob >> 9) & 1) << 5)); }
__host__ __device__ __forceinline__ void stage_rc(int b, int& R, int& C) { const int st = b / 1024, sb = b % 1024, swz = sb ^ (((sb >> 9) & 1) << 5); R = (st >> 1) * 16 + swz / 64; C = (st & 1) * 32 + (swz % 64) / 2; }
__host__ __device__ __forceinline__ int perm32(int rho) { const int n = rho >> 4, i = rho & 15; return 8 * (i >> 2) + 4 * n + (i & 3); }

struct Unit { int pm, pn; };
struct Gemm { const bf16_t* A; const bf16_t* Bt; int M, N, K; };

struct StaticOrder {
    int nM, nN, nwg, G, c;
    __host__ __device__ void init(int M, int N, int G_, int c_) { nM = M / BM; nN = N / BM; nwg = nM * nN; G = G_; c = c_; }
    __host__ __device__ bool next(int i, Unit& u) const {
        const long L = (long)i * G + c; if (L >= nwg) return false;
        int wgid = (int)L; { const int q = nwg / NXCD, r = nwg % NXCD, xcd = wgid % NXCD, off = wgid / NXCD; wgid = (xcd < r ? xcd * (q + 1) : r * (q + 1) + (xcd - r) * q) + off; }
        const int nig = WGM * nN, gid = wgid / nig, fm = gid * WGM, gsz = (nM - fm) < WGM ? (nM - fm) : WGM;
        u.pm = fm + ((wgid % nig) % gsz); u.pn = (wgid % nig) / gsz; return true;
    }
    __device__ __forceinline__ void a_ready(const Unit&) const {}
    __device__ __forceinline__ void done(const Unit&) const {}
};

__device__ __forceinline__ unsigned cvt_pk_bf16(float lo, float hi) { unsigned r; asm volatile("v_cvt_pk_bf16_f32 %0, %1, %2" : "=v"(r) : "v"(lo), "v"(hi)); return r; }
typedef unsigned u32x2 __attribute__((ext_vector_type(2)));
__device__ __forceinline__ float fsigm(float x) { return __builtin_amdgcn_rcpf(1.f + __builtin_amdgcn_exp2f(-1.4426950408889634f * x)); }
__device__ __forceinline__ float fsilu(float x) { return x * fsigm(x); }
__device__ __forceinline__ float bflo(unsigned w) { return __builtin_bit_cast(float, w << 16); }
__device__ __forceinline__ float bfhi(unsigned w) { return __builtin_bit_cast(float, w & 0xffff0000u); }

__device__ __forceinline__ u32x2 pk8_fp8(const f32x4& a, const f32x4& b) {
    u32x2 r; int w = 0;
    w = __builtin_amdgcn_cvt_pk_fp8_f32(__builtin_amdgcn_fmed3f(a[0], -448.f, 448.f), __builtin_amdgcn_fmed3f(a[1], -448.f, 448.f), w, false);
    w = __builtin_amdgcn_cvt_pk_fp8_f32(__builtin_amdgcn_fmed3f(a[2], -448.f, 448.f), __builtin_amdgcn_fmed3f(a[3], -448.f, 448.f), w, true); r.x = (unsigned)w; w = 0;
    w = __builtin_amdgcn_cvt_pk_fp8_f32(__builtin_amdgcn_fmed3f(b[0], -448.f, 448.f), __builtin_amdgcn_fmed3f(b[1], -448.f, 448.f), w, false);
    w = __builtin_amdgcn_cvt_pk_fp8_f32(__builtin_amdgcn_fmed3f(b[2], -448.f, 448.f), __builtin_amdgcn_fmed3f(b[3], -448.f, 448.f), w, true); r.y = (unsigned)w;
    return r;
}
constexpr int PF_OFF = 135168, PF_STRIDE = 3072;
__device__ __forceinline__ float rstd_fx(unsigned long long ss) { return __builtin_amdgcn_rsqf((float)ss * (1.0f / (1048576.0f * 1024.0f)) + 1e-6f); }
__device__ __forceinline__ void prefetch_rowstats(const unsigned long long* SS, const float* CV, const Unit& u, PG8_LAS unsigned char* buf, int wid, int lane) {
    if (wid < 2) __builtin_amdgcn_global_load_lds((const unsigned*)(SS + (size_t)u.pm * BM + wid * 128 + 2 * lane), (PG8_LAS unsigned*)(buf + wid * 1024), 16, 0, 0);
    else if (wid == 2) __builtin_amdgcn_global_load_lds((const unsigned*)(CV + (size_t)(u.pm >> 4) * 5632 + u.pn * BM + 4 * lane), (PG8_LAS unsigned*)(buf + 2048), 16, 0, 0);
}
struct EpiSwiglu8 {
    static constexpr bool PERM = true, AFTER_DRAIN = false, PREFETCH = true;
    unsigned char* O; int ldc; const unsigned long long* SS; const float* CV;
    __device__ __forceinline__ void prefetch(const Unit& u, PG8_LAS unsigned char* buf, int wid, int lane) const { prefetch_rowstats(SS, CV, u, buf, wid, lane); }
    __device__ __forceinline__ void operator()(const f32x4 (&acc)[2][2][4][2], const Unit& u, int wr, int wc, int fr, int fq, const PG8_LAS unsigned char* pf) const {
        const int row0 = u.pm * BM + wr * 64 + fr, col0 = u.pn * HALF + wc * 32 + 8 * fq;
        const PG8_LAS f32x4* cp = (const PG8_LAS f32x4*)(pf + 2048 + (wc * 32 + 8 * fq) * 4);
        const f32x4 ca0 = cp[0], ca1 = cp[1], cb0 = cp[32], cb1 = cp[33];
        const PG8_LAS unsigned long long* sp = (const PG8_LAS unsigned long long*)pf + wr * 64 + fr;
        float rsv[2][4];
#pragma unroll
        for (int ai = 0; ai < 2; ++ai)
#pragma unroll
            for (int m = 0; m < 4; ++m) rsv[ai][m] = rstd_fx(sp[ai * HALF + m * 16]);
#pragma unroll
        for (int ai = 0; ai < 2; ++ai)
#pragma unroll
            for (int m = 0; m < 4; ++m) {
                const int row = row0 + ai * HALF + m * 16;
                unsigned char* rowp = O + (size_t)row * ldc + col0;
                const float rs = rsv[ai][m];
                const f32x4 a0 = acc[ai][0][m][0] * rs + ca0, a1 = acc[ai][0][m][1] * rs + ca1, b0 = acc[ai][1][m][0] * rs + cb0, b1 = acc[ai][1][m][1] * rs + cb1;
                f32x4 h0, h1;
#pragma unroll
                for (int j = 0; j < 4; ++j) { h0[j] = fsilu(a0[j]) * b0[j]; h1[j] = fsilu(a1[j]) * b1[j]; }
                *(u32x2*)rowp = pk8_fp8(h0, h1);
            }
    }
};
struct EpiSwiglu {
    static constexpr bool PERM = true, AFTER_DRAIN = false, PREFETCH = false;
    bf16_t* O; int ldc;
    __device__ __forceinline__ void operator()(const f32x4 (&acc)[2][2][4][2], const Unit& u, int wr, int wc, int fr, int fq) const {
        const int row0 = u.pm * BM + wr * 64 + fr, col0 = u.pn * HALF + wc * 32 + 8 * fq;
#pragma unroll
        for (int ai = 0; ai < 2; ++ai)
#pragma unroll
            for (int m = 0; m < 4; ++m) {
                bf16_t* rowp = O + (size_t)(row0 + ai * HALF + m * 16) * ldc + col0;
                const f32x4 a0 = acc[ai][0][m][0], a1 = acc[ai][0][m][1], b0 = acc[ai][1][m][0], b1 = acc[ai][1][m][1];
                u32x4 w;
                w.x = cvt_pk_bf16(fsilu(a0[0]) * b0[0], fsilu(a0[1]) * b0[1]); w.y = cvt_pk_bf16(fsilu(a0[2]) * b0[2], fsilu(a0[3]) * b0[3]);
                w.z = cvt_pk_bf16(fsilu(a1[0]) * b1[0], fsilu(a1[1]) * b1[1]); w.w = cvt_pk_bf16(fsilu(a1[2]) * b1[2], fsilu(a1[3]) * b1[3]);
                *(u32x4*)rowp = w;
            }
    }
};

template <bool RF32, bool NOUT> struct EpiResid {
    static constexpr bool PERM = true, AFTER_DRAIN = false, PREFETCH = false;
    const void* R; bf16_t* C; const float* gate; bf16_t* V; const float* nw; const float* scm; unsigned long long* SS; float scale;
    __device__ __forceinline__ void operator()(const f32x4 (&acc)[2][2][4][2], const Unit& u, int wr, int wc, int fr, int fq) const {
        const int row0 = u.pm * BM + wr * 64 + fr, col0 = u.pn * BM + wc * 32 + 8 * fq;
        const size_t boff = (size_t)((u.pm * BM) >> 12) * 9216 + col0;
        f32x4 gv[2][2], g2[2][2]; f32x4 ssv[2] = {{0.f, 0.f, 0.f, 0.f}, {0.f, 0.f, 0.f, 0.f}};
#pragma unroll
        for (int bj = 0; bj < 2; ++bj)
#pragma unroll
            for (int n = 0; n < 2; ++n) { gv[bj][n] = *(const f32x4*)(gate + boff + bj * HALF + n * 4) * scale;
                if (NOUT) g2[bj][n] = *(const f32x4*)(nw + col0 + bj * HALF + n * 4) * (*(const f32x4*)(scm + boff + bj * HALF + n * 4) + 1.f); }
#pragma unroll
        for (int ai = 0; ai < 2; ++ai)
#pragma unroll
            for (int m = 0; m < 4; ++m) {
                const int row = row0 + ai * HALF + m * 16;
                const size_t ro = (size_t)row * 1024 + col0;
                float ssq = 0.f;
#pragma unroll
                for (int bj = 0; bj < 2; ++bj) {
                    f32x4 r0, r1;
                    if (RF32) { r0 = *(const f32x4*)((const float*)R + ro + bj * HALF); r1 = *(const f32x4*)((const float*)R + ro + bj * HALF + 4); }
                    else { const u32x4 w = *(const u32x4*)((const bf16_t*)R + ro + bj * HALF);
                        r0 = (f32x4){bflo(w.x), bfhi(w.x), bflo(w.y), bfhi(w.y)}; r1 = (f32x4){bflo(w.z), bfhi(w.z), bflo(w.w), bfhi(w.w)}; }
                    const f32x4 v0 = r0 + gv[bj][0] * acc[ai][bj][m][0], v1 = r1 + gv[bj][1] * acc[ai][bj][m][1];
                    u32x4 o; o.x = cvt_pk_bf16(v0[0], v0[1]); o.y = cvt_pk_bf16(v0[2], v0[3]); o.z = cvt_pk_bf16(v1[0], v1[1]); o.w = cvt_pk_bf16(v1[2], v1[3]);
                    *(u32x4*)(C + ro + bj * HALF) = o;
                    if (NOUT) {
                        ssq += ((v0[0] * v0[0] + v0[1] * v0[1]) + (v0[2] * v0[2] + v0[3] * v0[3])) + ((v1[0] * v1[0] + v1[1] * v1[1]) + (v1[2] * v1[2] + v1[3] * v1[3]));
                        const f32x4 y0 = v0 * g2[bj][0], y1 = v1 * g2[bj][1];
                        u32x4 p; p.x = cvt_pk_bf16(y0[0], y0[1]); p.y = cvt_pk_bf16(y0[2], y0[3]); p.z = cvt_pk_bf16(y1[0], y1[1]); p.w = cvt_pk_bf16(y1[2], y1[3]);
                        *(u32x4*)(V + ro + bj * HALF) = p;
                    }
                }
                if (NOUT) ssv[ai][m] = ssq;
            }
        if (NOUT) {
#pragma unroll
            for (int ai = 0; ai < 2; ++ai)
#pragma unroll
                for (int m = 0; m < 4; ++m) { float t = ssv[ai][m]; t += __shfl_xor(t, 16); t += __shfl_xor(t, 32); ssv[ai][m] = t; }
            if (fq == 0) {
#pragma unroll
                for (int ai = 0; ai < 2; ++ai)
#pragma unroll
                    for (int m = 0; m < 4; ++m)
                        (void)__hip_atomic_fetch_add(SS + row0 + ai * HALF + m * 16, (unsigned long long)(ssv[ai][m] * 1048576.0f), __ATOMIC_RELAXED, __HIP_MEMORY_SCOPE_AGENT);
            }
        }
    }
};

struct EpiInProj {
    static constexpr bool PERM = true, AFTER_DRAIN = false, PREFETCH = true;
    bf16_t *QN, *KVC, *KVS, *KVW, *RQ, *RK, *RV, *RG, *GA, *GB, *NG; const float *COS, *SIN; float qscale;
    const unsigned long long* SS; const float* CV;
    __device__ __forceinline__ void prefetch(const Unit& u, PG8_LAS unsigned char* buf, int wid, int lane) const { prefetch_rowstats(SS, CV, u, buf, wid, lane); }
    __device__ __forceinline__ void operator()(const f32x4 (&acc)[2][2][4][2], const Unit& u, int wr, int wc, int fr, int fq, const PG8_LAS unsigned char* pf) const {
        const int pn = u.pn;
        bf16_t* base; int ldc, colt, mode; float sc = 1.f;
        if (pn < 2)       { base = QN;  ldc = 512;  colt = pn * 256;        mode = 0; sc = qscale; }
        else if (pn == 2) { base = KVC; ldc = 256;  colt = 0;               mode = 0; }
        else if (pn == 3) { base = KVS; ldc = 256;  colt = 0;               mode = 0; }
        else if (pn == 4) { base = KVW; ldc = 256;  colt = 0;               mode = 0; }
        else if (pn < 7)  { base = RQ;  ldc = 512;  colt = (pn - 5) * 256;  mode = 1; }
        else if (pn < 9)  { base = RK;  ldc = 512;  colt = (pn - 7) * 256;  mode = 1; sc = 0.125f; }
        else if (pn < 11) { base = RV;  ldc = 512;  colt = (pn - 9) * 256;  mode = 0; }
        else if (pn < 13) { base = RG;  ldc = 512;  colt = (pn - 11) * 256; mode = 2; }
        else if (pn < 17) { base = GA;  ldc = 1024; colt = (pn - 13) * 256; mode = 3; }
        else if (pn < 21) { base = GB;  ldc = 1024; colt = (pn - 17) * 256; mode = 3; }
        else              { base = NG;  ldc = 32;   colt = 0;               mode = 4; }
        const int row0 = u.pm * BM + wr * 64 + fr, col0 = colt + wc * 32 + 8 * fq;
        const int i0 = (wc & 1) * 16 + 4 * fq;
        const PG8_LAS f32x4* cp = (const PG8_LAS f32x4*)(pf + 2048 + (wc * 32 + 8 * fq) * 4);
        f32x4 cv[2][2];
#pragma unroll
        for (int bj = 0; bj < 2; ++bj) { cv[bj][0] = cp[bj * 32]; cv[bj][1] = cp[bj * 32 + 1]; }
        const PG8_LAS unsigned long long* sp = (const PG8_LAS unsigned long long*)pf + wr * 64 + fr;
        float rsv[2][4];
#pragma unroll
        for (int ai = 0; ai < 2; ++ai)
#pragma unroll
            for (int m = 0; m < 4; ++m) rsv[ai][m] = rstd_fx(sp[ai * HALF + m * 16]);
#pragma unroll
        for (int ai = 0; ai < 2; ++ai)
#pragma unroll
            for (int m = 0; m < 4; ++m) {
                const int row = row0 + ai * HALF + m * 16;
                bf16_t* rowp = base + (size_t)row * ldc + col0;
                const float rs = rsv[ai][m];
                f32x4 c4 = {1.f, 1.f, 1.f, 1.f}, s4 = {0.f, 0.f, 0.f, 0.f};
                if (mode == 1) { c4 = *(const f32x4*)(COS + (size_t)(row & 4095) * 32 + i0); s4 = *(const f32x4*)(SIN + (size_t)(row & 4095) * 32 + i0); }
#pragma unroll
                for (int bj = 0; bj < 2; ++bj) {
                    f32x4 v0 = acc[ai][bj][m][0] * rs + cv[bj][0], v1 = acc[ai][bj][m][1] * rs + cv[bj][1];
                    if (mode == 0) { v0 = v0 * sc; v1 = v1 * sc; }
                    else if (mode == 1) {
                        f32x4 o0, o1;
                        o0[0] = (v0[0] * c4[0] - v0[1] * s4[0]) * sc; o0[1] = (v0[0] * s4[0] + v0[1] * c4[0]) * sc;
                        o0[2] = (v0[2] * c4[1] - v0[3] * s4[1]) * sc; o0[3] = (v0[2] * s4[1] + v0[3] * c4[1]) * sc;
                        o1[0] = (v1[0] * c4[2] - v1[1] * s4[2]) * sc; o1[1] = (v1[0] * s4[2] + v1[1] * c4[2]) * sc;
                        o1[2] = (v1[2] * c4[3] - v1[3] * s4[3]) * sc; o1[3] = (v1[2] * s4[3] + v1[3] * c4[3]) * sc;
                        v0 = o0; v1 = o1;
                    } else if (mode == 2) {
#pragma unroll
                        for (int j = 0; j < 4; ++j) { v0[j] = fsilu(v0[j]); v1[j] = fsilu(v1[j]); }
                    } else {
#pragma unroll
                        for (int j = 0; j < 4; ++j) { v0[j] = fsigm(v0[j]); v1[j] = fsigm(v1[j]); }
                    }
                    u32x4 w; w.x = cvt_pk_bf16(v0[0], v0[1]); w.y = cvt_pk_bf16(v0[2], v0[3]); w.z = cvt_pk_bf16(v1[0], v1[1]); w.w = cvt_pk_bf16(v1[2], v1[3]);
                    if (mode != 4) *(u32x4*)(rowp + bj * HALF) = w;
                    else if (bj == 0 && wc == 0) *(u32x4*)rowp = w;
                }
            }
    }
};

template <bool ADD> struct EpiMix {
    static constexpr bool PERM = true, AFTER_DRAIN = false, PREFETCH = false;
    const bf16_t* Gt; bf16_t* O;
    __device__ __forceinline__ void operator()(const f32x4 (&acc)[2][2][4][2], const Unit& u, int wr, int wc, int fr, int fq) const {
        const int row0 = u.pm * BM + wr * 64 + fr, col0 = u.pn * BM + wc * 32 + 8 * fq;
#pragma unroll
        for (int ai = 0; ai < 2; ++ai)
#pragma unroll
            for (int m = 0; m < 4; ++m) {
                const size_t ro = (size_t)(row0 + ai * HALF + m * 16) * 1024 + col0;
#pragma unroll
                for (int bj = 0; bj < 2; ++bj) {
                    const u32x4 g = *(const u32x4*)(Gt + ro + bj * HALF);
                    f32x4 v0 = acc[ai][bj][m][0], v1 = acc[ai][bj][m][1];
                    v0[0] *= bflo(g.x); v0[1] *= bfhi(g.x); v0[2] *= bflo(g.y); v0[3] *= bfhi(g.y);
                    v1[0] *= bflo(g.z); v1[1] *= bfhi(g.z); v1[2] *= bflo(g.w); v1[3] *= bfhi(g.w);
                    if (ADD) { const u32x4 p = *(const u32x4*)(O + ro + bj * HALF);
                        v0[0] += bflo(p.x); v0[1] += bfhi(p.x); v0[2] += bflo(p.y); v0[3] += bfhi(p.y);
                        v1[0] += bflo(p.z); v1[1] += bfhi(p.z); v1[2] += bflo(p.w); v1[3] += bfhi(p.w); }
                    u32x4 w; w.x = cvt_pk_bf16(v0[0], v0[1]); w.y = cvt_pk_bf16(v0[2], v0[3]); w.z = cvt_pk_bf16(v1[0], v1[1]); w.w = cvt_pk_bf16(v1[2], v1[3]);
                    *(u32x4*)(O + ro + bj * HALF) = w;
                }
            }
    }
};

template <class Epi, class Sched, bool ALIGN_EPI = false, bool SP2 = false, bool FP8 = false>
__device__ __forceinline__ void gemm_phase(PG8_LAS unsigned char* lds, const Gemm g, const Sched& S, const Epi& E) {
    const int tid = threadIdx.x, wid = __builtin_amdgcn_readfirstlane(tid >> 6), lane = tid & 63, wr = wid >> 2, wc = wid & 3, fr = lane & 15, fq = lane >> 4;
    const int K = g.K, nt = K / BK;
    unsigned voffA[2], voffB[2];
#pragma unroll
    for (int i = 0; i < 2; ++i) { int R, C; stage_rc(tid * 16 + i * 8192, R, C); const int Rb = Epi::PERM ? ((R & ~31) + perm32(R & 31)) : R;
        voffA[i] = (unsigned)(R * K + C) * 2u; voffB[i] = (unsigned)(Rb * K + C) * 2u; }
    const size_t kstep = (size_t)(BK * 2);
    const size_t hstep = (size_t)HALF * K * 2;
    const size_t tstep = 2 * hstep;
    const unsigned ldsw = (unsigned)wid * 1024u;
    const int aoff = lds_byte(wr * 64 + fr, fq * 8), boff = lds_byte(wc * 32 + fr, fq * 8);
#define PG8_SA(b, h) (((b) * 2 + (h)) * HTB)
#define PG8_SB(b, h) ((4 + (b) * 2 + (h)) * HTB)
#define PG8_STAGE(bufoff, gbase, voff) do { _Pragma("unroll") for (int _i = 0; _i < 2; ++_i) \
        __builtin_amdgcn_global_load_lds((const unsigned*)((const char*)(gbase) + (voff)[_i]), (PG8_LAS unsigned*)(lds + (bufoff) + ldsw + _i * 8192), 16, 0, 0); } while (0)
#define PG8_LDA(dst, b, h) do { _Pragma("unroll") for (int m = 0; m < 4; ++m) _Pragma("unroll") for (int k = 0; k < 2; ++k) dst[m][k] = *(const PG8_LAS bf16x8*)(lds + PG8_SA(b, h) + aoff + m * 2048 + k * 1024); } while (0)
#define PG8_LDB(dst, b, h) do { _Pragma("unroll") for (int n = 0; n < 2; ++n) _Pragma("unroll") for (int k = 0; k < 2; ++k) dst[n][k] = *(const PG8_LAS bf16x8*)(lds + PG8_SB(b, h) + boff + n * 2048 + k * 1024); } while (0)
#define PG8_CAT8(lo, hi) __builtin_shufflevector(__builtin_bit_cast(v4i_t, lo), __builtin_bit_cast(v4i_t, hi), 0, 1, 2, 3, 4, 5, 6, 7)
#define PG8_MMA(ai, bj, At, Bt) do { __builtin_amdgcn_s_setprio(1); _Pragma("unroll") for (int m = 0; m < 4; ++m) _Pragma("unroll") for (int n = 0; n < 2; ++n) { \
        if constexpr (FP8) { asm volatile("v_mfma_scale_f32_16x16x128_f8f6f4 %0, %1, %2, %0, %3, %4 op_sel_hi:[0,0,0]" : "+v"(acc[ai][bj][m][n]) : "v"(PG8_CAT8(Bt[n][0], Bt[n][1])), "v"(PG8_CAT8(At[m][0], At[m][1])), "v"(fp8_sw), "v"(fp8_sa)); } \
        else { _Pragma("unroll") for (int k = 0; k < 2; ++k) acc[ai][bj][m][n] = __builtin_amdgcn_mfma_f32_16x16x32_bf16(Bt[n][k], At[m][k], acc[ai][bj][m][n], 0, 0, 0); } } \
        __builtin_amdgcn_s_setprio(0); } while (0)
#define PG8_WAIT_V(n) asm volatile("s_waitcnt vmcnt(" #n ")" ::: "memory")
#define PG8_WAIT_L(n) asm volatile("s_waitcnt lgkmcnt(" #n ")" ::: "memory")
#define PG8_BAR __builtin_amdgcn_s_barrier()
#define PG8_SCHED __builtin_amdgcn_sched_barrier(0)
    int fp8_sw = 0x79797979, fp8_sa = 0x7f7f7f7f; (void)fp8_sw; (void)fp8_sa;
    Unit cur, nxt; int ui = 0;
    if (!S.next(0, cur)) return;
    f32x4 acc[2][2][4][2];
#pragma unroll
    for (int a = 0; a < 2; ++a)
#pragma unroll
        for (int b = 0; b < 2; ++b)
#pragma unroll
            for (int m = 0; m < 4; ++m)
#pragma unroll
                for (int n = 0; n < 2; ++n) acc[a][b][m][n] = (f32x4){0.f, 0.f, 0.f, 0.f};
    bf16x8 At[4][2], B0[2][2], B1[2][2];
    const char* cA = (const char*)g.A + (size_t)cur.pm * tstep; const char* cB = (const char*)g.Bt + (size_t)cur.pn * tstep;
    S.a_ready(cur);
    int pfb = 0;
    if constexpr (Epi::PREFETCH) E.prefetch(cur, lds + PF_OFF, wid, lane);
    if constexpr (SP2) {
        PG8_STAGE(PG8_SB(0, 0), cB, voffB); PG8_STAGE(PG8_SB(0, 1), cB + hstep, voffB); PG8_STAGE(PG8_SA(0, 0), cA, voffA); PG8_STAGE(PG8_SA(0, 1), cA + hstep, voffA);
        if (wr == 1) PG8_BAR;
        PG8_WAIT_V(2); PG8_BAR;
        PG8_STAGE(PG8_SB(1, 0), cB + kstep, voffB); PG8_STAGE(PG8_SA(1, 0), cA + kstep, voffA); PG8_STAGE(PG8_SB(1, 1), cB + hstep + kstep, voffB);
        PG8_WAIT_V(6); PG8_BAR;
    } else {
        PG8_STAGE(PG8_SB(0, 0), cB, voffB); PG8_STAGE(PG8_SA(0, 0), cA, voffA); PG8_STAGE(PG8_SB(0, 1), cB + hstep, voffB); PG8_STAGE(PG8_SA(0, 1), cA + hstep, voffA);
        if (wr == 1) PG8_BAR;
        PG8_WAIT_V(4); PG8_BAR;
        PG8_STAGE(PG8_SB(1, 0), cB + kstep, voffB); PG8_STAGE(PG8_SA(1, 0), cA + kstep, voffA); PG8_STAGE(PG8_SB(1, 1), cB + hstep + kstep, voffB);
        PG8_WAIT_V(6); PG8_BAR;
    }
    for (;;) {
        const bool has_next = S.next(ui + 1, nxt);
        if constexpr (Epi::PREFETCH) { if (has_next) E.prefetch(nxt, lds + PF_OFF + (pfb == 2 ? 0 : pfb + 1) * PF_STRIDE, wid, lane); }
        const char* nA = has_next ? (const char*)g.A + (size_t)nxt.pm * tstep : cA; const char* nB = has_next ? (const char*)g.Bt + (size_t)nxt.pn * tstep : cB;
        for (int t = 0; t < nt; t += 2) {
            const bool last = (t == nt - 2);
            const char* a1 = cA + (size_t)(t + 1) * kstep;
            const char* a2 = last ? nA : cA + (size_t)(t + 2) * kstep; const char* b2 = last ? nB : cB + (size_t)(t + 2) * kstep;
            const char* a3 = a2 + kstep; const char* b3 = b2 + kstep;
            if (last && has_next) S.a_ready(nxt);
            if constexpr (SP2) {
            PG8_LDB(B0, 0, 0); PG8_LDB(B1, 0, 1); PG8_SCHED; PG8_LDA(At, 0, 0); PG8_STAGE(PG8_SA(1, 1), a1 + hstep, voffA);
            PG8_WAIT_V(8); PG8_WAIT_L(0); PG8_BAR; PG8_MMA(0, 0, At, B0); PG8_MMA(0, 1, At, B1); PG8_BAR; PG8_SCHED;
            PG8_LDA(At, 0, 1); PG8_STAGE(PG8_SB(0, 0), b2, voffB); PG8_STAGE(PG8_SB(0, 1), b2 + hstep, voffB); PG8_STAGE(PG8_SA(0, 0), a2, voffA);
            PG8_WAIT_V(8); PG8_WAIT_L(0); PG8_BAR; PG8_MMA(1, 0, At, B0); PG8_MMA(1, 1, At, B1); PG8_BAR; PG8_SCHED;
            PG8_LDB(B0, 1, 0); PG8_LDB(B1, 1, 1); PG8_SCHED; PG8_LDA(At, 1, 0); PG8_STAGE(PG8_SA(0, 1), a2 + hstep, voffA);
            PG8_WAIT_V(8); PG8_WAIT_L(0); PG8_BAR; PG8_MMA(0, 0, At, B0); PG8_MMA(0, 1, At, B1); PG8_BAR; PG8_SCHED;
            PG8_LDA(At, 1, 1); PG8_STAGE(PG8_SB(1, 0), b3, voffB); PG8_STAGE(PG8_SB(1, 1), b3 + hstep, voffB); PG8_STAGE(PG8_SA(1, 0), a3, voffA);
            PG8_WAIT_V(8); PG8_WAIT_L(0); PG8_BAR; PG8_MMA(1, 0, At, B0); PG8_MMA(1, 1, At, B1); PG8_BAR; PG8_SCHED;
            } else {
            PG8_LDB(B0, 0, 0); PG8_SCHED; PG8_LDA(At, 0, 0); PG8_STAGE(PG8_SA(1, 1), a1 + hstep, voffA);
            PG8_WAIT_L(8); PG8_BAR; PG8_WAIT_L(0); PG8_MMA(0, 0, At, B0); PG8_BAR; PG8_SCHED;
            PG8_LDB(B1, 0, 1); PG8_STAGE(PG8_SB(0, 0), b2, voffB);
            PG8_BAR; PG8_WAIT_L(0); PG8_MMA(0, 1, At, B1); PG8_BAR;
            PG8_LDA(At, 0, 1); PG8_STAGE(PG8_SA(0, 0), a2, voffA);
            PG8_BAR; PG8_WAIT_L(0); PG8_MMA(1, 0, At, B0); PG8_BAR; PG8_SCHED;
            PG8_STAGE(PG8_SB(0, 1), b2 + hstep, voffB);
            PG8_WAIT_V(6); PG8_BAR; PG8_MMA(1, 1, At, B1); PG8_BAR;
            PG8_LDB(B0, 1, 0); PG8_SCHED; PG8_LDA(At, 1, 0); PG8_STAGE(PG8_SA(0, 1), a2 + hstep, voffA);
            PG8_WAIT_L(8); PG8_BAR; PG8_WAIT_L(0); PG8_MMA(0, 0, At, B0); PG8_BAR; PG8_SCHED;
            PG8_LDB(B1, 1, 1); PG8_STAGE(PG8_SB(1, 0), b3, voffB);
            PG8_BAR; PG8_WAIT_L(0); PG8_MMA(0, 1, At, B1); PG8_BAR;
            PG8_LDA(At, 1, 1); PG8_STAGE(PG8_SA(1, 0), a3, voffA);
            PG8_BAR; PG8_WAIT_L(0); PG8_MMA(1, 0, At, B0); PG8_BAR; PG8_SCHED;
            PG8_STAGE(PG8_SB(1, 1), b3 + hstep, voffB);
            PG8_WAIT_V(6); PG8_BAR; PG8_MMA(1, 1, At, B1); PG8_BAR;
            }
        }
        if constexpr (ALIGN_EPI) { if (wr == 0) PG8_BAR; }
        if constexpr (FP8) asm volatile("s_nop 15\n\ts_nop 15" ::: "memory");
        if constexpr (!Epi::AFTER_DRAIN) { if constexpr (Epi::PREFETCH) { E(acc, cur, wr, wc, fr, fq, lds + PF_OFF + pfb * PF_STRIDE); pfb = pfb == 2 ? 0 : pfb + 1; } else E(acc, cur, wr, wc, fr, fq); S.done(cur); }
        if (!has_next) break;
#pragma unroll
        for (int a = 0; a < 2; ++a)
#pragma unroll
            for (int b = 0; b < 2; ++b)
#pragma unroll
                for (int m = 0; m < 4; ++m)
#pragma unroll
                    for (int n = 0; n < 2; ++n) acc[a][b][m][n] = (f32x4){0.f, 0.f, 0.f, 0.f};
        cur = nxt; cA = nA; cB = nB; ++ui;
        if constexpr (ALIGN_EPI) { if (wr == 1) PG8_BAR; }
    }
    PG8_WAIT_V(0);
    if constexpr (!ALIGN_EPI) { if (wr == 0) PG8_BAR; }
    PG8_BAR;
    if constexpr (Epi::AFTER_DRAIN) { E.fused(acc, cur, wr, wc, fr, fq, lds, wid, lane); S.done(cur); }
#undef PG8_SA
#undef PG8_SB
#undef PG8_STAGE
#undef PG8_LDA
#undef PG8_LDB
#undef PG8_MMA
#undef PG8_CAT8
#undef PG8_WAIT_V
#undef PG8_WAIT_L
#undef PG8_BAR
#undef PG8_SCHED
}
}

constexpr int NWAVES = 8, NTHR = 512;
constexpr int NB = 8, SEQ = 4096, TT = NB * SEQ, DM = 1024, FF = 2816, NPROJ = 5632;
constexpr float QSCALE = 0.125f * 1.4426950408889634f;
constexpr float NEGBIG = -1e30f;

constexpr size_t MiB = 1u << 20;
constexpr size_t WS_CTL = 0, CTL_ZERO_BYTES = 1 * MiB;
constexpr size_t WS_MOD = 1 * MiB;
constexpr size_t WS_COS = 1 * MiB + 512 * 1024, WS_SIN = 2 * MiB;
constexpr size_t WS_SMALL = 2 * MiB + 512 * 1024;
constexpr size_t WS_CW1K = 3 * MiB, WS_CW1V = 3 * MiB + 512 * 1024;
constexpr size_t WS_KC = 4 * MiB, WS_VCT = 4 * MiB + 512 * 1024;
constexpr size_t WS_WNU = 5 * MiB, WS_WRU = 6 * MiB, WS_WO = 7 * MiB;
constexpr size_t WS_W1A = 9 * MiB, WS_W1B = 20 * MiB, WS_WIN = 26 * MiB, WS_W2A = 37 * MiB, WS_W2B = 48 * MiB;
constexpr size_t WS_U = 56 * MiB;
constexpr size_t WS_ONSA = 56 * MiB, WS_ORET = 88 * MiB;
constexpr size_t WS_HACT = 120 * MiB;
constexpr size_t WS_QN = 120 * MiB, WS_KVC = 152 * MiB, WS_KVS = 168 * MiB, WS_KVW = 184 * MiB, WS_RQ = 200 * MiB, WS_RK = 232 * MiB, WS_RV = 264 * MiB, WS_RG = 296 * MiB;
constexpr size_t WS_GA = 328 * MiB, WS_GB = 392 * MiB, WS_NG = 456 * MiB, WS_SLOC = 458 * MiB, WS_STOT = 490 * MiB, WS_END = 494 * MiB;
constexpr size_t WS_H3 = 328 * MiB;
constexpr size_t WS_MIXED = 200 * MiB;
constexpr int CW_BAR = 4096;
constexpr size_t WS_SS2 = WS_CTL + 256 * 1024, WS_SS3 = WS_CTL + 512 * 1024;
constexpr size_t WS_CV2 = WS_MOD + 294912, WS_CV3 = WS_SMALL + 131072;

constexpr int RING_BYTES = 131072, LDSCTL_OFF = RING_BYTES, MISC_OFF = LDSCTL_OFF + 320, LDS_BYTES = 147456;

#define GAS __attribute__((address_space(1)))
#define LAS __attribute__((address_space(3)))
typedef unsigned short bf16;
typedef unsigned v4u __attribute__((ext_vector_type(4)));
typedef unsigned v2u __attribute__((ext_vector_type(2)));
typedef float f32x4 __attribute__((ext_vector_type(4)));
typedef float f32x16 __attribute__((ext_vector_type(16)));
typedef short bf16x8 __attribute__((ext_vector_type(8)));
typedef short s16x4 __attribute__((ext_vector_type(4)));
typedef GAS unsigned gu32;
#define RLX_AGENT __ATOMIC_RELAXED, __HIP_MEMORY_SCOPE_AGENT
#define LDS_WAIT() asm volatile("s_waitcnt lgkmcnt(0)" ::: "memory")
using pg8::bflo; using pg8::bfhi; using pg8::fsilu; using pg8::fsigm;
#define XB_TMO      128
#define XB_XCNT(j)  (256  + 64 * (j))
#define XB_XSUB(j)  (1280 + 64 * (j))
#define XB_XGEN(j)  (2304 + 64 * (j))
#define XB_TOP      3328
#define XB_TOPGEN   3392
#define XCD_BAR_WORDS 3456
#define XB_SPIN_CAP (1u << 18)

__device__ __forceinline__ unsigned xb_ld(unsigned* p)              { return __hip_atomic_load(p, __ATOMIC_RELAXED, __HIP_MEMORY_SCOPE_AGENT); }
__device__ __forceinline__ unsigned xb_add(unsigned* p, unsigned v) { return __hip_atomic_fetch_add(p, v, __ATOMIC_RELAXED, __HIP_MEMORY_SCOPE_AGENT); }
__device__ __forceinline__ unsigned xb_xcc_id() { return (unsigned)__builtin_amdgcn_s_getreg((3 << 11) | 20) & 0xFu; }
#define XB_SPIN(cond, bar) do { unsigned _sp = 0; while (cond) { __builtin_amdgcn_s_sleep(1); \
    if ((++_sp & 255u) == 0u) { if (xb_ld(&(bar)[XB_TMO])) break; if (_sp > XB_SPIN_CAP) { atomicAdd(&(bar)[XB_TMO], 1u); break; } } } } while (0)

struct XcdBarrier {
    unsigned* bar; unsigned x;
    volatile LAS unsigned* st;
};

__device__ __forceinline__ XcdBarrier xcd_barrier_post(unsigned* bar, volatile LAS unsigned* st) {
    XcdBarrier b; b.bar = bar; b.x = xb_xcc_id(); b.st = st;
    if (threadIdx.x == 0) (void)xb_add(&bar[XB_XCNT(b.x)], 1u);
    return b;
}
__device__ __forceinline__ void xcd_barrier_complete(unsigned* bar, unsigned x, unsigned& nloc, unsigned& nx) {
    const unsigned G = gridDim.x * gridDim.y * gridDim.z;
    unsigned sum, cnt, mine, sp = 0u;
    for (;;) {
        sum = 0u; cnt = 0u; mine = 0u;
#pragma unroll
        for (unsigned j = 0; j < 16; ++j) { const unsigned c = xb_ld(&bar[XB_XCNT(j)]); sum += c; cnt += (c > 0u) ? 1u : 0u; mine = (j == x) ? c : mine; }
        if (sum == G) break;
        __builtin_amdgcn_s_sleep(1);
        if ((++sp & 255u) == 0u) { if (xb_ld(&bar[XB_TMO])) break; if (sp > XB_SPIN_CAP) { atomicAdd(&bar[XB_TMO], 1u); break; } }
    }
    nloc = mine > 0u ? mine : 1u; nx = cnt > 0u ? cnt : 1u;
}

__device__ __forceinline__ void xcd_barrier(const XcdBarrier& b) {
    asm volatile("s_waitcnt vmcnt(0)" ::: "memory");
    __syncthreads();
    if (threadIdx.x == 0) {
        unsigned* bar = b.bar;
        __builtin_amdgcn_s_waitcnt(0);
        unsigned nloc = b.st[0], nx = b.st[1];
        if (nloc == 0u) { xcd_barrier_complete(bar, b.x, nloc, nx); b.st[0] = nloc; b.st[1] = nx; }
        const unsigned old = xb_add(&bar[XB_XSUB(b.x)], 1u);
        const unsigned gen = old / nloc;
        if (old + 1u == (gen + 1u) * nloc) {
            __builtin_amdgcn_fence(__ATOMIC_RELEASE, "agent");
            asm volatile("s_waitcnt vmcnt(0)" ::: "memory");
            const unsigned og = xb_add(&bar[XB_TOP], 1u);
            const unsigned tg = og / nx;
            if (og + 1u == (tg + 1u) * nx) xb_add(&bar[XB_TOPGEN], 1u);
            else XB_SPIN(xb_ld(&bar[XB_TOPGEN]) == tg, bar);
            __builtin_amdgcn_fence(__ATOMIC_ACQUIRE, "agent");
            xb_add(&bar[XB_XGEN(b.x)], 1u);
            asm volatile("s_waitcnt vmcnt(0)" ::: "memory");
        } else {
            XB_SPIN(xb_ld(&bar[XB_XGEN(b.x)]) == gen, bar);
            __builtin_amdgcn_fence(__ATOMIC_ACQUIRE, "agent");
            asm volatile("s_waitcnt vmcnt(0)" ::: "memory");
        }
    }
    __syncthreads();
}

__device__ __forceinline__ float wave_sum(float v) {
#pragma unroll
    for (int o = 1; o < 64; o <<= 1) v += __shfl_xor(v, o);
    return v;
}
__device__ __forceinline__ bf16x8 ld16g(const bf16* p) { return __builtin_bit_cast(bf16x8, *(const GAS v4u*)p); }
__device__ __forceinline__ bf16x8 ld16l(const LAS unsigned char* p) { return *(const LAS bf16x8*)p; }
typedef short v4i16_t __attribute__((ext_vector_type(4)));
__device__ __forceinline__ s16x4 vtr(const LAS unsigned char* p) { return __builtin_bit_cast(s16x4, __builtin_amdgcn_ds_read_tr16_b64_v4i16((LAS v4i16_t*)p)); }
__device__ __forceinline__ bf16x8 cat8(s16x4 a, s16x4 b) { return (bf16x8){a[0], a[1], a[2], a[3], b[0], b[1], b[2], b[3]}; }
__device__ __forceinline__ float quad_xor1(float x) { return __builtin_bit_cast(float, __builtin_amdgcn_update_dpp(0, __builtin_bit_cast(int, x), 0xB1, 0xF, 0xF, true)); }
__device__ __forceinline__ float quad_xor2(float x) { return __builtin_bit_cast(float, __builtin_amdgcn_update_dpp(0, __builtin_bit_cast(int, x), 0x4E, 0xF, 0xF, true)); }
__device__ __forceinline__ float xmax(float x) { return fmaxf(x, __shfl_xor(x, 32)); }
__device__ __forceinline__ float xsum(float x) { return x + __shfl_xor(x, 32); }
__device__ __forceinline__ float xpartner(float x, int h) { (void)h; return __shfl_xor(x, 32); }
__device__ __forceinline__ int crow(int r, int hi) { return (r & 3) + 8 * (r >> 2) + 4 * hi; }
__device__ __forceinline__ f32x4 mfma16(bf16x8 a, bf16x8 b, f32x4 c) { return __builtin_amdgcn_mfma_f32_16x16x32_bf16(a, b, c, 0, 0, 0); }
__device__ __forceinline__ f32x16 mfma32(bf16x8 a, bf16x8 b, f32x16 c) { return __builtin_amdgcn_mfma_f32_32x32x16_bf16(a, b, c, 0, 0, 0); }
typedef float f32x2_t __attribute__((ext_vector_type(2))); typedef __bf16 bf16x2_t __attribute__((ext_vector_type(2)));
__device__ __forceinline__ unsigned cvtpk(float lo, float hi) { f32x2_t v = {lo, hi}; bf16x2_t b = __builtin_convertvector(v, bf16x2_t); return __builtin_bit_cast(unsigned, b); }
__device__ __forceinline__ float fexp2(float x) { return __builtin_amdgcn_exp2f(x); }
__device__ __forceinline__ float log2g(int h) {
    return h == 0 ? -0.04580368961312479f : h == 1 ? -0.02272007650008353f : h == 2 ? -0.011315313227834146f : h == 3 ? -0.005646563141142063f
         : h == 4 ? -0.0028205190623786626f : h == 5 ? -0.0014095702546713536f : h == 6 ? -0.0007046129765893727f : -0.0003522634716290214f;
}

struct Args {
    const float *x, *c, *ada_w, *ada_b, *norm1_w, *ffn1_w_in, *ffn1_w_out, *norm2_w, *w_in, *cmp_k_pe, *cmp_k_w1, *cmp_k_w2, *cmp_v_pe, *cmp_v_w1, *cmp_v_w2,
                *ret_norm_w, *w_nsa_up, *w_ret_up, *w_out, *norm3_w, *ffn2_w_in, *ffn2_w_out, *final_norm_w;
    float* out; unsigned char* ws; int ph_lo, ph_hi;
};

template <int MAT> __device__ __forceinline__ int srccol(int r) {
    if (MAT == 1) { const int p = r >> 8, q = r & 255; return q < 128 ? 128 * p + q : FF + 128 * p + (q - 128); }
    if (MAT == 2) {
        if (r < 1280) return r;
        if (r < 2304) { const int base = r < 1792 ? 1304 : 1816; const int l = (r - 1280) & 511; const int hd = l >> 6, p = l & 63; return base + hd * 64 + ((p & 1) ? (p >> 1) + 32 : (p >> 1)); }
        if (r < 5376) return r + 24;
        if (r < 5400) return r - 5376 + 1280;
        return -1;
    }
    return r;
}
__device__ __forceinline__ unsigned f2bf(float f) { unsigned u = __builtin_bit_cast(unsigned, f); return (u + 0x7fffu + ((u >> 16) & 1u)) >> 16; }
__device__ __forceinline__ unsigned pk2(float lo, float hi) { return f2bf(lo) | (f2bf(hi) << 16); }
template <int MAT> __device__ __forceinline__ void transpose_item(const float* W, int K, int N, bf16* WT, LAS float* scr, int item, int nblk, int lane) {
    const int kb = item / nblk, nb = item % nblk, k0 = 64 * kb, r0 = 32 * nb;
    const int col = srccol<MAT>(r0 + (lane & 31));
    float tv[32];
#pragma unroll
    for (int i = 0; i < 32; ++i) { const int kk = 2 * i + (lane >> 5); tv[i] = col >= 0 ? W[(size_t)(k0 + kk) * N + col] : 0.f; }
#pragma unroll
    for (int i = 0; i < 32; ++i) { const int kk = 2 * i + (lane >> 5); scr[kk * 33 + (lane & 31)] = tv[i]; }
    LDS_WAIT(); asm volatile("" ::: "memory");
    const int c = lane & 7;
#pragma unroll
    for (int j = 0; j < 4; ++j) { const int n = (lane >> 3) + 8 * j; const LAS float* s = scr + (8 * c) * 33 + n;
        v4u o; o.x = pk2(s[0 * 33], s[1 * 33]); o.y = pk2(s[2 * 33], s[3 * 33]); o.z = pk2(s[4 * 33], s[5 * 33]); o.w = pk2(s[6 * 33], s[7 * 33]);
        *(GAS v4u*)(WT + (size_t)(r0 + n) * K + k0 + 8 * c) = o; }
    LDS_WAIT(); asm volatile("" ::: "memory");
}
__device__ __forceinline__ void transpose_item_fp8(const float* W, int K, int N, unsigned char* WT, LAS float* scr, int item, int nblk, int lane) {
    const int kb = item / nblk, nb = item % nblk, k0 = 64 * kb, r0 = 32 * nb;
    const int col = r0 + (lane & 31);
    float tv[32];
#pragma unroll
    for (int i = 0; i < 32; ++i) { const int kk = 2 * i + (lane >> 5); tv[i] = W[(size_t)(k0 + kk) * N + col]; }
#pragma unroll
    for (int i = 0; i < 32; ++i) { const int kk = 2 * i + (lane >> 5); scr[kk * 33 + (lane & 31)] = tv[i] * 64.f; }
    LDS_WAIT(); asm volatile("" ::: "memory");
    const int c = lane & 7;
#pragma unroll
    for (int j = 0; j < 4; ++j) { const int n = (lane >> 3) + 8 * j; const LAS float* s = scr + (8 * c) * 33 + n;
        const f32x4 lo = {s[0 * 33], s[1 * 33], s[2 * 33], s[3 * 33]}, hi = {s[4 * 33], s[5 * 33], s[6 * 33], s[7 * 33]};
        *(GAS v2u*)(WT + (size_t)(r0 + n) * K + k0 + 8 * c) = pg8::pk8_fp8(lo, hi); }
    LDS_WAIT(); asm volatile("" ::: "memory");
}
__device__ const double ROPE_INVF[32] = {1.0, 0.7498942093324559, 0.5623413251903491, 0.4216965034285822, 0.31622776601683794, 0.23713737056616552, 0.1778279410038923, 0.1333521432163324, 0.1, 0.07498942093324558, 0.05623413251903491, 0.042169650342858224, 0.03162277660168379, 0.023713737056616554, 0.01778279410038923, 0.01333521432163324, 0.01, 0.007498942093324558, 0.005623413251903491, 0.004216965034285823, 0.0031622776601683794, 0.0023713737056616554, 0.0017782794100389228, 0.001333521432163324, 0.001, 0.0007498942093324559, 0.0005623413251903491, 0.00042169650342858224, 0.00031622776601683794, 0.00023713737056616554, 0.00017782794100389227, 0.0001333521432163324};

__device__ __forceinline__ void p0_prologue(const Args& a, LAS unsigned char* lds, int tid, int lane, int wave, int vcu, int G) {
    unsigned char* ws = a.ws;
    for (int item = blockIdx.x; item < 144; item += G) {
        LAS float* scs = (LAS float*)lds;
        LAS float* red = (LAS float*)(lds + 32768);
        for (int e = tid; e < 8192; e += NTHR) scs[e] = fsilu(a.c[e]);
        __syncthreads();
        const int n0 = 64 * item, cl = tid & 63, kg = tid >> 6;
        float acc[8];
#pragma unroll
        for (int b = 0; b < 8; ++b) acc[b] = 0.f;
#pragma unroll 16
        for (int k = kg * 128; k < kg * 128 + 128; ++k) { const float w = a.ada_w[(size_t)k * 9216 + n0 + cl];
#pragma unroll
            for (int b = 0; b < 8; ++b) acc[b] += scs[b * 1024 + k] * w; }
#pragma unroll
        for (int b = 0; b < 8; ++b) red[(kg * 8 + b) * 64 + cl] = acc[b];
        __syncthreads();
        { const int b = tid >> 6; float s = a.ada_b[n0 + cl];
#pragma unroll
          for (int g = 0; g < 8; ++g) s += red[(g * 8 + b) * 64 + cl];
          ((float*)(ws + WS_MOD))[b * 9216 + n0 + cl] = s; }
        __syncthreads();
    }
    for (int item = blockIdx.x - 144; item < 2; item += G) {
        if (item < 0) continue;
        const float* pe = item == 0 ? a.cmp_k_pe : a.cmp_v_pe; const float* w1 = item == 0 ? a.cmp_k_w1 : a.cmp_v_w1;
        LAS float* red = (LAS float*)lds;
        const int j = tid & 127, kg = tid >> 7; float s = 0.f;
#pragma unroll 4
        for (int k = kg * 512; k < kg * 512 + 512; ++k) s += pe[k] * w1[(size_t)k * 128 + j];
        red[kg * 128 + j] = s;
        __syncthreads();
        if (tid < 128) ((float*)(ws + WS_SMALL + 1024 * item))[tid] = red[tid] + red[128 + tid] + red[256 + tid] + red[384 + tid];
        __syncthreads();
    }
    for (int e = blockIdx.x * NTHR + tid; e < SEQ * 32; e += G * NTHR) {
        const int t = e >> 5, i = e & 31;
        const double ang = (double)t * ROPE_INVF[i];
        const double n = __builtin_rint(ang * 0.6366197723675814);
        double y = __builtin_fma(-n, 1.5707963267948966, ang); y = __builtin_fma(-n, 6.123233995736766e-17, y);
        const double y2 = y * y;
        double sn = -1.0 / 6227020800.0; sn = sn * y2 + 1.0 / 39916800.0; sn = sn * y2 - 1.0 / 362880.0; sn = sn * y2 + 1.0 / 5040.0; sn = sn * y2 - 1.0 / 120.0; sn = sn * y2 + 1.0 / 6.0; sn = y - y * y2 * sn;
        double cs = 1.0 / 87178291200.0; cs = cs * y2 - 1.0 / 479001600.0; cs = cs * y2 + 1.0 / 3628800.0; cs = cs * y2 - 1.0 / 40320.0; cs = cs * y2 + 1.0 / 720.0; cs = cs * y2 - 1.0 / 24.0; cs = cs * y2 + 0.5; cs = 1.0 - y2 * cs;
        const int q = ((int)n) & 3;
        const double sv = q == 0 ? sn : q == 1 ? cs : q == 2 ? -sn : -cs;
        const double cv = q == 0 ? cs : q == 1 ? -sn : q == 2 ? -cs : sn;
        ((float*)(ws + WS_COS))[e] = (float)cv; ((float*)(ws + WS_SIN))[e] = (float)sv;
    }
    __syncthreads();
    LAS float* scr = (LAS float*)(lds + wave * 16384);
    const int gw = vcu * NWAVES + wave, NGW = G * NWAVES;
    constexpr int I1 = 16 * 176, I2 = 44 * 32, I3 = 16 * 176, I4 = 8 * 32, I5 = 8 * 32, I6 = 16 * 32, I7 = I1, I8 = I2, I9 = 32 * 4, I10 = 32 * 4, I11 = 2 * 2, I12 = 2 * 2;
    constexpr int NITEMS = I1 + I2 + I3 + I4 + I5 + I6 + I7 + I8 + I9 + I10 + I11 + I12;
    for (int it = gw; it < NITEMS; it += NGW) {
        int r = it;
        if (r < I1) { transpose_item<1>(a.ffn1_w_in, 1024, 2 * FF, (bf16*)(ws + WS_W1A), scr, r, 176, lane); continue; } r -= I1;
        if (r < I2) { transpose_item<0>(a.ffn1_w_out, FF, 1024, (bf16*)(ws + WS_W1B), scr, r, 32, lane); continue; } r -= I2;
        if (r < I3) { transpose_item<2>(a.w_in, 1024, 5400, (bf16*)(ws + WS_WIN), scr, r, 176, lane); continue; } r -= I3;
        if (r < I4) { transpose_item<0>(a.w_nsa_up, 512, 1024, (bf16*)(ws + WS_WNU), scr, r, 32, lane); continue; } r -= I4;
        if (r < I5) { transpose_item<0>(a.w_ret_up, 512, 1024, (bf16*)(ws + WS_WRU), scr, r, 32, lane); continue; } r -= I5;
        if (r < I6) { transpose_item<0>(a.w_out, 1024, 1024, (bf16*)(ws + WS_WO), scr, r, 32, lane); continue; } r -= I6;
        if (r < I7) { transpose_item<1>(a.ffn2_w_in, 1024, 2 * FF, (bf16*)(ws + WS_W2A), scr, r, 176, lane); continue; } r -= I7;
        if (r < I8) { transpose_item_fp8(a.ffn2_w_out, FF, 1024, (unsigned char*)(ws + WS_W2B), scr, r, 32, lane); continue; } r -= I8;
        if (r < I9) { transpose_item<0>(a.cmp_k_w1, 2048, 128, (bf16*)(ws + WS_CW1K), scr, r, 4, lane); continue; } r -= I9;
        if (r < I10) { transpose_item<0>(a.cmp_v_w1, 2048, 128, (bf16*)(ws + WS_CW1V), scr, r, 4, lane); continue; } r -= I10;
        if (r < I11) { transpose_item<0>(a.cmp_k_w2, 128, 64, (bf16*)(ws + WS_SMALL + 4096), scr, r, 2, lane); continue; } r -= I11;
        transpose_item<0>(a.cmp_v_w2, 128, 64, (bf16*)(ws + WS_SMALL + 4096 + 16384), scr, r, 2, lane);
    }
}

template <bool XF32> __device__ __forceinline__ void load_row16(const void* X, size_t row, int lane, f32x4 (&v)[4]) {
    if (XF32) { const GAS f32x4* xr = (const GAS f32x4*)((const float*)X + row * DM);
        v[0] = xr[2 * lane]; v[1] = xr[2 * lane + 1]; v[2] = xr[128 + 2 * lane]; v[3] = xr[128 + 2 * lane + 1]; }
    else { const GAS v4u* xr = (const GAS v4u*)((const bf16*)X + row * DM);
        const v4u a = xr[lane], b = xr[64 + lane];
        v[0] = (f32x4){bflo(a.x), bfhi(a.x), bflo(a.y), bfhi(a.y)}; v[1] = (f32x4){bflo(a.z), bfhi(a.z), bflo(a.w), bfhi(a.w)};
        v[2] = (f32x4){bflo(b.x), bfhi(b.x), bflo(b.y), bfhi(b.y)}; v[3] = (f32x4){bflo(b.z), bfhi(b.z), bflo(b.w), bfhi(b.w)}; }
}
template <bool XF32> __device__ __forceinline__ void norm_mod_phase(const void* X, const float* w, const float* mod, int ch_sh, int ch_sc, bf16* U, int gw, int NGW, int lane) {
    for (int row0 = gw; row0 < TT; row0 += 4 * NGW) {
        f32x4 v[4][4];
#pragma unroll
        for (int i = 0; i < 4; ++i) { const int row = row0 + i * NGW; load_row16<XF32>(X, (size_t)(row < TT ? row : row0), lane, v[i]); }
#pragma unroll
        for (int i = 0; i < 4; ++i) { const int row = row0 + i * NGW; if (row >= TT) break;
            float ss = 0.f;
#pragma unroll
            for (int j = 0; j < 4; ++j) ss += (v[i][j].x * v[i][j].x + v[i][j].y * v[i][j].y) + (v[i][j].z * v[i][j].z + v[i][j].w * v[i][j].w);
            const float rstd = __builtin_amdgcn_rsqf(wave_sum(ss) * (1.f / DM) + 1e-6f);
            const float* mb = mod + (size_t)(row >> 12) * 9216;
            GAS v4u* o16 = (GAS v4u*)(U + (size_t)row * DM);
#pragma unroll
            for (int c = 0; c < 2; ++c) {
                f32x4 y[2];
#pragma unroll
                for (int q = 0; q < 2; ++q) { const int i4 = 128 * c + 2 * lane + q;
                    const f32x4 wv = ((const f32x4*)w)[i4], sh = ((const f32x4*)(mb + ch_sh * 1024))[i4], sc = ((const f32x4*)(mb + ch_sc * 1024))[i4];
                    y[q] = v[i][2 * c + q] * rstd * wv * (sc + 1.f) + sh; }
                v4u o; o.x = cvtpk(y[0].x, y[0].y); o.y = cvtpk(y[0].z, y[0].w); o.z = cvtpk(y[1].x, y[1].y); o.w = cvtpk(y[1].z, y[1].w);
                o16[64 * c + lane] = o;
            }
        }
    }
}
__device__ __forceinline__ void final_norm_phase(const bf16* H, float* O, const float* w, int gw, int NGW, int lane) {
    for (int row0 = gw; row0 < TT; row0 += 4 * NGW) {
        f32x4 v[4][4];
#pragma unroll
        for (int i = 0; i < 4; ++i) { const int row = row0 + i * NGW; load_row16<false>(H, (size_t)(row < TT ? row : row0), lane, v[i]); }
#pragma unroll
        for (int i = 0; i < 4; ++i) { const int row = row0 + i * NGW; if (row >= TT) break;
            float ss = 0.f;
#pragma unroll
            for (int j = 0; j < 4; ++j) ss += (v[i][j].x * v[i][j].x + v[i][j].y * v[i][j].y) + (v[i][j].z * v[i][j].z + v[i][j].w * v[i][j].w);
            const float rstd = __builtin_amdgcn_rsqf(wave_sum(ss) * (1.f / DM) + 1e-6f);
            GAS f32x4* orow = (GAS f32x4*)(O + (size_t)row * DM);
#pragma unroll
            for (int c = 0; c < 2; ++c)
#pragma unroll
                for (int q = 0; q < 2; ++q) { const int i4 = 128 * c + 2 * lane + q; orow[i4] = v[i][2 * c + q] * rstd * ((const f32x4*)w)[i4]; }
        }
    }
}

__device__ __forceinline__ void cvec_phase(const unsigned char* ws_c, const float* mod, LAS unsigned char* lds, int tid, int lane, int gw, int NGW) {
    unsigned char* ws = (unsigned char*)ws_c;
    LAS float* shl = (LAS float*)lds;
    for (int e = tid; e < 16384; e += NTHR) { const int r = e & 8191; shl[e] = mod[(size_t)(r >> 10) * 9216 + ((e >> 13) ? 6 : 3) * 1024 + (r & 1023)]; }
    v4u wa[2][3], wb[2][3];
#pragma unroll
    for (int w = 0; w < 2; ++w)
#pragma unroll
        for (int i = 0; i < 3; ++i) { const int n = gw + i * NGW; const GAS v4u* wrow = (const GAS v4u*)((const bf16*)(ws + (w ? WS_W2A : WS_WIN)) + (size_t)(n < NPROJ ? n : gw) * DM);
            wa[w][i] = wrow[lane]; wb[w][i] = wrow[64 + lane]; }
    __syncthreads();
#pragma unroll
    for (int w = 0; w < 2; ++w)
#pragma unroll
        for (int i = 0; i < 3; ++i) { const int n = gw + i * NGW; if (n >= NPROJ) continue;
            const v4u a = wa[w][i], b = wb[w][i];
            const f32x4 w0 = {bflo(a.x), bfhi(a.x), bflo(a.y), bfhi(a.y)}, w1 = {bflo(a.z), bfhi(a.z), bflo(a.w), bfhi(a.w)};
            const f32x4 w2 = {bflo(b.x), bfhi(b.x), bflo(b.y), bfhi(b.y)}, w3 = {bflo(b.z), bfhi(b.z), bflo(b.w), bfhi(b.w)};
            float mine = 0.f;
#pragma unroll
            for (int bb = 0; bb < 8; ++bb) { const LAS f32x4* sp = (const LAS f32x4*)(shl + w * 8192 + bb * 1024);
                const f32x4 t = w0 * sp[2 * lane] + w1 * sp[2 * lane + 1] + w2 * sp[128 + 2 * lane] + w3 * sp[128 + 2 * lane + 1];
                const float sum = wave_sum((t.x + t.y) + (t.z + t.w));
                mine = lane == bb ? sum : mine; }
            if (lane < 8) ((float*)(ws + (w ? WS_CV3 : WS_CV2)))[(size_t)lane * NPROJ + n] = mine; }
    __syncthreads();
}

__device__ __forceinline__ void compress_unit(int u, const unsigned char* ws_c, LAS unsigned char* lds, int lane, int wave) {
    asm volatile("" : "+v"(lane));
    unsigned char* ws = (unsigned char*)ws_c;
    const int kv = u & 1, g = (u >> 1) & 1, b = (u >> 2) & 7, rt = u >> 5, n0 = 32 * rt;
    const bf16* KVC = (const bf16*)(ws + WS_KVC);
    const bf16* W1t = (const bf16*)(ws + (kv ? WS_CW1V : WS_CW1K));
    const bf16* W2t = (const bf16*)(ws + WS_SMALL + 4096 + 16384 * kv);
    const float* bias1 = (const float*)(ws + WS_SMALL + 1024 * kv);
    const int fr = lane & 15, fq = lane >> 4, rh = wave >> 2, cg = wave & 3;
    const int nrow = n0 + 16 * rh + fr;
    const bf16* arow = KVC + (size_t)b * SEQ * 256 + kv * 128 + g * 64 + 8 * fq;
    f32x4 acc[8];
#pragma unroll
    for (int nt = 0; nt < 8; ++nt) acc[nt] = (f32x4){0.f, 0.f, 0.f, 0.f};
    const bf16* b0p = W1t + (size_t)fr * 2048 + 8 * fq;
#pragma unroll 4
    for (int kk = 0; kk < 16; ++kk) { const int ks = 16 * cg + kk;
        int tok = 16 * nrow + (ks >> 1); tok = tok > SEQ - 1 ? SEQ - 1 : tok;
        const bf16x8 af = ld16g(arow + (size_t)tok * 256 + 32 * (ks & 1));
#pragma unroll
        for (int nt = 0; nt < 8; ++nt) acc[nt] = mfma16(af, ld16g(b0p + (size_t)nt * 16 * 2048 + 32 * ks), acc[nt]);
    }
    LAS float* red = (LAS float*)(lds + 16384);
    LAS bf16* hb = (LAS bf16*)lds;
#pragma unroll
    for (int nt = 0; nt < 8; ++nt)
#pragma unroll
        for (int r = 0; r < 4; ++r) red[(cg * 32 + 16 * rh + 4 * fq + r) * 132 + 16 * nt + fr] = acc[nt][r];
    __syncthreads();
    { const int tid2 = wave * 64 + lane;
      const int row = tid2 >> 4, c0 = (tid2 & 15) * 8;
#pragma unroll
      for (int j = 0; j < 8; ++j) { const int col = c0 + j;
          const float v = (red[(0 * 32 + row) * 132 + col] + red[(1 * 32 + row) * 132 + col]) + (red[(2 * 32 + row) * 132 + col] + red[(3 * 32 + row) * 132 + col]) + bias1[col];
          hb[row * 136 + col] = (bf16)f2bf(fsilu(v)); } }
    __syncthreads();
    const int dt = cg;
    f32x4 acc2 = {0.f, 0.f, 0.f, 0.f};
#pragma unroll
    for (int ks = 0; ks < 4; ++ks) {
        const bf16x8 a2 = ld16l((const LAS unsigned char*)(hb + (16 * rh + fr) * 136 + 32 * ks + 8 * fq));
        const bf16x8 b2 = ld16g(W2t + (size_t)(16 * dt + fr) * 128 + 32 * ks + 8 * fq);
        acc2 = mfma16(a2, b2, acc2);
    }
    const int d = 16 * dt + fr, nb = n0 + 16 * rh + 4 * fq, bg = b * 2 + g;
    if (kv == 0) { bf16* KC = (bf16*)(ws + WS_KC);
#pragma unroll
        for (int r = 0; r < 4; ++r) KC[((size_t)bg * 256 + nb + r) * 64 + d] = (bf16)f2bf(acc2[r]);
    } else { bf16* VCT = (bf16*)(ws + WS_VCT);
        const int pos = (nb & ~12) | ((nb & 4) << 1) | ((nb & 8) >> 1);
        v2u o; o.x = cvtpk(acc2[0], acc2[1]); o.y = cvtpk(acc2[2], acc2[3]);
        *(GAS v2u*)(VCT + ((size_t)bg * 64 + d) * 256 + pos) = o; }
    __syncthreads();
}

constexpr int RS = 144;
template <bool SCALE> __device__ __forceinline__ void stage_chunk(const bf16* src, LAS unsigned char* dst, int tid, float lg) {
#pragma unroll
    for (int i = 0; i < 2; ++i) { const int idx = tid + NTHR * i, row = idx >> 3, ch = idx & 7;
        v4u q = *(const GAS v4u*)(src + (size_t)row * 512 + 8 * ch);
        if (SCALE) { const float f = fexp2(lg * (float)(127 - row));
            q.x = cvtpk(bflo(q.x) * f, bfhi(q.x) * f); q.y = cvtpk(bflo(q.y) * f, bfhi(q.y) * f); q.z = cvtpk(bflo(q.z) * f, bfhi(q.z) * f); q.w = cvtpk(bflo(q.w) * f, bfhi(q.w) * f); }
        *(LAS v4u*)(dst + row * RS + ch * 16) = q; }
}
struct ChunkRegs { v4u k[2], v[2]; };
__device__ __forceinline__ ChunkRegs load_chunk(int u, const unsigned char* ws, int tid) {
    const int n = u & 31, h = (u >> 5) & 7, b = u >> 8;
    const size_t off = ((size_t)b * SEQ + 128 * n) * 512 + h * 64;
    ChunkRegs c;
#pragma unroll
    for (int i = 0; i < 2; ++i) { const int idx = tid + NTHR * i, row = idx >> 3, ch = idx & 7;
        c.k[i] = *(const GAS v4u*)((const bf16*)(ws + WS_RK) + off + (size_t)row * 512 + 8 * ch);
        c.v[i] = *(const GAS v4u*)((const bf16*)(ws + WS_RV) + off + (size_t)row * 512 + 8 * ch); }
    return c;
}
template <bool SCALE> __device__ __forceinline__ void store_chunk(const ChunkRegs& c, LAS unsigned char* Ks, LAS unsigned char* Vs, int tid, float lg) {
#pragma unroll
    for (int i = 0; i < 2; ++i) { const int idx = tid + NTHR * i, row = idx >> 3, ch = idx & 7;
        v4u q = c.k[i];
        if (SCALE) { const float f = fexp2(lg * (float)(127 - row));
            q.x = cvtpk(bflo(q.x) * f, bfhi(q.x) * f); q.y = cvtpk(bflo(q.y) * f, bfhi(q.y) * f); q.z = cvtpk(bflo(q.z) * f, bfhi(q.z) * f); q.w = cvtpk(bflo(q.w) * f, bfhi(q.w) * f); }
        *(LAS v4u*)(Ks + row * RS + ch * 16) = q; *(LAS v4u*)(Vs + row * RS + ch * 16) = c.v[i]; }
}
__device__ __forceinline__ void sloc_unit(int u, const ChunkRegs& cr, unsigned char* ws, LAS unsigned char* lds, int tid, int lane, int wave, f32x4 (&run)[2], bool last) {
    asm volatile("" : "+v"(tid), "+v"(lane));
    const int n = u & 31, h = (u >> 5) & 7, b = u >> 8; const float lg = log2g(h);
    const size_t tok0 = (size_t)b * SEQ + 128 * n;
    LAS unsigned char* Ks = lds; LAS unsigned char* Vs = lds + 128 * RS;
    store_chunk<true>(cr, Ks, Vs, tid, lg);
    __syncthreads();
    const int fr = lane & 15, fq = lane >> 4, mt = wave >> 1, ntb = 2 * (wave & 1);
    f32x4 acc[2] = {{0.f, 0.f, 0.f, 0.f}, {0.f, 0.f, 0.f, 0.f}};
    const int roff = (8 * fq + (fr >> 2)) * RS + 8 * (lane & 3);
#pragma unroll
    for (int s = 0; s < 4; ++s) {
        const bf16x8 af = cat8(vtr(Vs + 32 * s * RS + roff + 32 * mt), vtr(Vs + (32 * s + 4) * RS + roff + 32 * mt));
#pragma unroll
        for (int t2 = 0; t2 < 2; ++t2) { const int nt = ntb + t2;
            const bf16x8 bf_ = cat8(vtr(Ks + 32 * s * RS + roff + 32 * nt), vtr(Ks + (32 * s + 4) * RS + roff + 32 * nt));
            acc[t2] = mfma16(af, bf_, acc[t2]); }
    }
    const float cd = fexp2(lg * 128.f);
    float* SL = (float*)(ws + WS_SLOC) + (size_t)u * 4096;
#pragma unroll
    for (int t2 = 0; t2 < 2; ++t2) {
#pragma unroll
        for (int r = 0; r < 4; ++r) SL[(16 * mt + 4 * fq + r) * 64 + 16 * (ntb + t2) + fr] = run[t2][r];
        run[t2] = run[t2] * cd + acc[t2]; }
    if (last) { float* ST = (float*)(ws + WS_STOT) + (size_t)(u >> 3) * 4096;
#pragma unroll
        for (int t2 = 0; t2 < 2; ++t2)
#pragma unroll
            for (int r = 0; r < 4; ++r) ST[(16 * mt + 4 * fq + r) * 64 + 16 * (ntb + t2) + fr] = run[t2][r]; }
    __syncthreads();
}
__device__ __forceinline__ void ret_unit(int u, const ChunkRegs& cr, unsigned char* ws, const float* ret_norm_w, LAS unsigned char* lds, int tid, int lane, int wave) {
    asm volatile("" : "+v"(tid), "+v"(lane));
    const int n = u & 31, h = (u >> 5) & 7, b = u >> 8; const float lg = log2g(h);
    const size_t tok0 = (size_t)b * SEQ + 128 * n;
    LAS unsigned char* Ks = lds; LAS unsigned char* Vs = lds + 128 * RS; LAS unsigned char* St = lds + 256 * RS;
    const int fr = lane & 15, fq = lane >> 4;
    const int i = 16 * wave + fr; const size_t tok = tok0 + i;
    bf16x8 qf[2]; v2u rgv[4];
#pragma unroll
    for (int ks = 0; ks < 2; ++ks) qf[ks] = ld16g((const bf16*)(ws + WS_RQ) + tok * 512 + h * 64 + 32 * ks + 8 * fq);
#pragma unroll
    for (int mt = 0; mt < 4; ++mt) rgv[mt] = *(const GAS v2u*)((const bf16*)(ws + WS_RG) + tok * 512 + h * 64 + 16 * mt + 4 * fq);
    {
        const float cd8 = fexp2(lg * 1024.f);
        const float* ST = (const float*)(ws + WS_STOT) + (size_t)((u - n) >> 3) * 4096 + tid * 8;
        f32x4 s0 = {0.f, 0.f, 0.f, 0.f}, s1 = {0.f, 0.f, 0.f, 0.f};
        for (int gq = 0; gq < (n >> 3); ++gq) { const f32x4 a0 = *(const GAS f32x4*)(ST + (size_t)gq * 4096), a1 = *(const GAS f32x4*)(ST + (size_t)gq * 4096 + 4); s0 = s0 * cd8 + a0; s1 = s1 * cd8 + a1; }
        { const float ci = fexp2(lg * 128.f * (float)(n & 7)); const float* SL = (const float*)(ws + WS_SLOC) + (size_t)u * 4096 + tid * 8;
          s0 = s0 * ci + *(const GAS f32x4*)SL; s1 = s1 * ci + *(const GAS f32x4*)(SL + 4); }
        v4u o; o.x = cvtpk(s0[0], s0[1]); o.y = cvtpk(s0[2], s0[3]); o.z = cvtpk(s1[0], s1[1]); o.w = cvtpk(s1[2], s1[3]);
        *(LAS v4u*)(St + (tid >> 3) * RS + (tid & 7) * 16) = o;
    }
    store_chunk<false>(cr, Ks, Vs, tid, lg);
    __syncthreads();
    f32x4 o[4];
    const float qd = fexp2(lg * (float)(i + 1));
#pragma unroll
    for (int mt = 0; mt < 4; ++mt) { o[mt] = (f32x4){0.f, 0.f, 0.f, 0.f};
#pragma unroll
        for (int ks = 0; ks < 2; ++ks) o[mt] = mfma16(ld16l(St + (16 * mt + fr) * RS + (32 * ks + 8 * fq) * 2), qf[ks], o[mt]);
        o[mt] = o[mt] * qd; }
    v2u P[8];
#pragma unroll
    for (int jt = 0; jt < 8; ++jt) {
        P[jt] = (v2u){0u, 0u};
        if (jt <= wave) {
            f32x4 sa = {0.f, 0.f, 0.f, 0.f};
#pragma unroll
            for (int ks = 0; ks < 2; ++ks) sa = mfma16(ld16l(Ks + (16 * jt + fr) * RS + (32 * ks + 8 * fq) * 2), qf[ks], sa);
            float p[4];
#pragma unroll
            for (int r = 0; r < 4; ++r) { const int dl = i - (16 * jt + 4 * fq + r); p[r] = dl >= 0 ? sa[r] * fexp2(lg * (float)dl) : 0.f; }
            P[jt].x = cvtpk(p[0], p[1]); P[jt].y = cvtpk(p[2], p[3]);
        }
    }
    const int voff = (4 * fq + (fr >> 2)) * RS + 8 * (lane & 3);
#pragma unroll
    for (int s = 0; s < 4; ++s) {
        if (2 * s <= wave) {
            const bf16x8 pb = __builtin_bit_cast(bf16x8, (v4u){P[2 * s].x, P[2 * s].y, P[2 * s + 1].x, P[2 * s + 1].y});
#pragma unroll
            for (int mt = 0; mt < 4; ++mt) {
                const bf16x8 vf = cat8(vtr(Vs + 32 * s * RS + voff + 32 * mt), vtr(Vs + (32 * s + 16) * RS + voff + 32 * mt));
                o[mt] = mfma16(vf, pb, o[mt]); }
        }
    }
    float sm = 0.f;
#pragma unroll
    for (int mt = 0; mt < 4; ++mt) sm += (o[mt][0] + o[mt][1]) + (o[mt][2] + o[mt][3]);
    sm += __shfl_xor(sm, 16); sm += __shfl_xor(sm, 32);
    const float mu = sm * (1.f / 64.f);
    float sq = 0.f;
#pragma unroll
    for (int mt = 0; mt < 4; ++mt) { o[mt] = o[mt] - mu; sq += (o[mt][0] * o[mt][0] + o[mt][1] * o[mt][1]) + (o[mt][2] * o[mt][2] + o[mt][3] * o[mt][3]); }
    sq += __shfl_xor(sq, 16); sq += __shfl_xor(sq, 32);
    const float rstd = __builtin_amdgcn_rsqf(sq * (1.f / 64.f) + 1e-6f);
#pragma unroll
    for (int mt = 0; mt < 4; ++mt) { const int dv = 16 * mt + 4 * fq;
        const f32x4 w4 = *(const f32x4*)(ret_norm_w + h * 64 + dv);
        const v2u rg = rgv[mt];
        const f32x4 y = o[mt] * rstd * w4;
        v2u ov; ov.x = cvtpk(y[0] * bflo(rg.x), y[1] * bfhi(rg.x)); ov.y = cvtpk(y[2] * bflo(rg.y), y[3] * bfhi(rg.y));
        *(GAS v2u*)((bf16*)(ws + WS_ORET) + tok * 512 + h * 64 + dv) = ov; }
    __syncthreads();
}

constexpr int KRS = 144, VRS = 192;
constexpr int ATT_KB = 64 * KRS, ATT_VB = 64 * VRS, ATT_BUF = ATT_KB + ATT_VB;
constexpr int KC_RS = 144, VCT_RS = 528;
constexpr int KC_OFF = 0, VCT_OFF = 256 * KC_RS, ATT_OFF = VCT_OFF + 64 * VCT_RS;
__device__ __forceinline__ bf16x8 packp(const f32x16& p, int s) {
    return __builtin_bit_cast(bf16x8, (v4u){cvtpk(p[8 * s], p[8 * s + 1]), cvtpk(p[8 * s + 2], p[8 * s + 3]), cvtpk(p[8 * s + 4], p[8 * s + 5]), cvtpk(p[8 * s + 6], p[8 * s + 7])});
}
template <int MODE, bool SHIFT> __device__ __forceinline__ void attend(unsigned (&outp)[2][8], const bf16x8 (&qf)[4], float negm, const bf16* Kg, const bf16* Vg, int qb, int tl, unsigned long long selmask, float gate,
                                                            LAS unsigned char* lds, int tid, int lane, int wave) {
    asm volatile("" : "+v"(tid), "+v"(lane));
    const int r32 = lane & 31, h = lane >> 5;
    const bool grpB = wave >= 4;
    float l = 0.f;
    f32x16 o[2], cinit;
#pragma unroll
    for (int r = 0; r < 16; ++r) { o[0][r] = 0.f; o[1][r] = 0.f; cinit[r] = SHIFT ? negm : 0.f; }
    const int j0 = MODE == 0 ? 0 : (qb > 8 ? qb - 8 : 0);
    const int voff = (4 * h + ((lane & 15) >> 2)) * VRS + (16 * ((lane >> 4) & 1) + 4 * (lane & 3)) * 2;
    const int koff = r32 * KRS + 16 * h;
    const int srow = tid >> 3, sch = tid & 7;
    const bf16* kgp = Kg + (size_t)srow * 256 + 8 * sch; const bf16* vgp = Vg + (size_t)srow * 256 + 8 * sch;
    LAS unsigned char* stgK = lds + ATT_OFF; LAS unsigned char* stgV = stgK + 2 * ATT_KB;
    LAS unsigned char* wK = stgK + srow * KRS + sch * 16; LAS unsigned char* wV = stgV + srow * VRS + sch * 16;
    v4u kA = *(const GAS v4u*)(kgp + (size_t)(64 * j0) * 256), vA = *(const GAS v4u*)(vgp + (size_t)(64 * j0) * 256), kB = kA, vB = vA;
    __syncthreads();
    *(LAS v4u*)wK = kA; *(LAS v4u*)wV = vA;
    if (j0 < qb) { kA = *(const GAS v4u*)(kgp + (size_t)(64 * (j0 + 1)) * 256); vA = *(const GAS v4u*)(vgp + (size_t)(64 * (j0 + 1)) * 256); }
    __syncthreads();
    v4u pkp[4] = {{0u, 0u, 0u, 0u}, {0u, 0u, 0u, 0u}, {0u, 0u, 0u, 0u}, {0u, 0u, 0u, 0u}}; bool actp = false;
    int kb = 0, vcur = 0, vprev = 0;
#define ATT_VF(VS, S2, MD) cat8(vtr((VS) + (16 * (S2)) * VRS + voff + 64 * (MD)), vtr((VS) + (16 * (S2) + 8) * VRS + voff + 64 * (MD)))
#define ATT_PV(VS, PK) do { \
        _Pragma("unroll") for (int s2 = 0; s2 < 4; ++s2) { \
            _Pragma("unroll") for (int md = 0; md < 2; ++md) o[md] = mfma32(ATT_VF(VS, s2, md), __builtin_bit_cast(bf16x8, PK[s2]), o[md]); } } while (0)
#define ATT_STEP(J, KP, VP, KQ, VQ) do { \
        LAS unsigned char* Ks = stgK + kb * ATT_KB; LAS unsigned char* Vc = stgV + vcur * ATT_VB; LAS unsigned char* Vp = stgV + vprev * ATT_VB; \
        if ((J) + 2 <= qb) { KQ = *(const GAS v4u*)(kgp + (size_t)(64 * ((J) + 2)) * 256); VQ = *(const GAS v4u*)(vgp + (size_t)(64 * ((J) + 2)) * 256); } \
        const bool rowok = MODE == 0 ? (((selmask >> (J)) & 1ull) != 0ull) : true; \
        const bool act = __any(rowok); \
        if (grpB && actp) ATT_PV(Vp, pkp); \
        v4u pk[4] = {{0u, 0u, 0u, 0u}, {0u, 0u, 0u, 0u}, {0u, 0u, 0u, 0u}, {0u, 0u, 0u, 0u}}; \
        if (act) { \
            bf16x8 kf[8]; \
            _Pragma("unroll") for (int i = 0; i < 8; ++i) kf[i] = ld16l(Ks + koff + (i >> 2) * 32 * KRS + (i & 3) * 32); \
            f32x16 s0 = cinit, s1 = cinit; \
            _Pragma("unroll") for (int ks = 0; ks < 4; ++ks) { s0 = mfma32(kf[ks], qf[ks], s0); s1 = mfma32(kf[4 + ks], qf[ks], s1); } \
            const bool lo_edge = (MODE == 1) && ((J) == qb - 8), hi_edge = ((J) == qb); \
            if (lo_edge || hi_edge) { \
                _Pragma("unroll") for (int r = 0; r < 16; ++r) { const int kl = crow(r, h); \
                    const bool ok0 = (!hi_edge || kl <= tl) && (!lo_edge || kl > tl), ok1 = (!hi_edge || kl + 32 <= tl) && (!lo_edge || kl + 32 > tl); \
                    s0[r] = ok0 ? s0[r] : NEGBIG; s1[r] = ok1 ? s1[r] : NEGBIG; } \
            } \
            float ls = 0.f; \
            _Pragma("unroll") for (int r = 0; r < 16; ++r) { s0[r] = fexp2(s0[r]); s1[r] = fexp2(s1[r]); ls += s0[r] + s1[r]; } \
            const unsigned rmask = rowok ? 0xffffffffu : 0u; \
            l += rowok ? ls : 0.f; \
            if (MODE == 1 || __all(rowok)) {                  \
            _Pragma("unroll") for (int s2 = 0; s2 < 4; ++s2) { const f32x16& p = (s2 >> 1) ? s1 : s0; const int e = 8 * (s2 & 1); \
                pk[s2] = (v4u){cvtpk(p[e], p[e + 1]), cvtpk(p[e + 2], p[e + 3]), cvtpk(p[e + 4], p[e + 5]), cvtpk(p[e + 6], p[e + 7])}; } \
            } else { \
            _Pragma("unroll") for (int s2 = 0; s2 < 4; ++s2) { const f32x16& p = (s2 >> 1) ? s1 : s0; const int e = 8 * (s2 & 1); \
                pk[s2] = (v4u){cvtpk(p[e], p[e + 1]) & rmask, cvtpk(p[e + 2], p[e + 3]) & rmask, cvtpk(p[e + 4], p[e + 5]) & rmask, cvtpk(p[e + 6], p[e + 7]) & rmask}; } } \
        } \
        if (!grpB) { if (act) ATT_PV(Vc, pk); } \
        else { _Pragma("unroll") for (int s2 = 0; s2 < 4; ++s2) pkp[s2] = pk[s2]; actp = act; } \
        const int vnext = vcur == 2 ? 0 : vcur + 1; \
        if ((J) < qb) { *(LAS v4u*)(wK + (1 - kb) * ATT_KB) = KP; *(LAS v4u*)(wV + vnext * ATT_VB) = VP; } \
        __syncthreads(); \
        kb ^= 1; vprev = vcur; vcur = vnext; \
    } while (0)
    int j = j0;
    for (; j + 1 <= qb; j += 2) { ATT_STEP(j, kA, vA, kB, vB); ATT_STEP(j + 1, kB, vB, kA, vA); }
    if (j <= qb) ATT_STEP(j, kA, vA, kB, vB);
    if (grpB && actp) { LAS unsigned char* Vp = stgV + vprev * ATT_VB; ATT_PV(Vp, pkp); }
#undef ATT_STEP
#undef ATT_PV
#undef ATT_VF
    l += __shfl_xor(l, 32);
    const float sc = gate / l;
#pragma unroll
    for (int md = 0; md < 2; ++md)
#pragma unroll
        for (int r = 0; r < 8; ++r) outp[md][r] = cvtpk(bflo(outp[md][r]) + o[md][2 * r] * sc, bfhi(outp[md][r]) + o[md][2 * r + 1] * sc);
}

constexpr int KCMAX_OFF = ATT_OFF + 2 * ATT_KB + 3 * ATT_VB;
__device__ __forceinline__ void load_cmp_images(int bg, const unsigned char* ws, LAS unsigned char* lds, int tid) {
    asm volatile("" : "+v"(tid));
    const bf16* KC = (const bf16*)(ws + WS_KC) + (size_t)bg * 256 * 64; const bf16* VCT = (const bf16*)(ws + WS_VCT) + (size_t)bg * 64 * 256;
    if (tid == 0) *(LAS unsigned*)(lds + KCMAX_OFF) = 0u;
    __syncthreads();
    float mx2 = 0.f;
#pragma unroll
    for (int i = 0; i < 4; ++i) { const int idx = tid + NTHR * i;
        const v4u kq = *(const GAS v4u*)(KC + (size_t)idx * 8);
        *(LAS v4u*)(lds + KC_OFF + (idx >> 3) * KC_RS + (idx & 7) * 16) = kq;
        *(LAS v4u*)(lds + VCT_OFF + (idx >> 5) * VCT_RS + (idx & 31) * 16) = *(const GAS v4u*)(VCT + (size_t)idx * 8);
        float p2 = (bflo(kq.x) * bflo(kq.x) + bfhi(kq.x) * bfhi(kq.x)) + (bflo(kq.y) * bflo(kq.y) + bfhi(kq.y) * bfhi(kq.y)) + (bflo(kq.z) * bflo(kq.z) + bfhi(kq.z) * bfhi(kq.z)) + (bflo(kq.w) * bflo(kq.w) + bfhi(kq.w) * bfhi(kq.w));
        p2 += __shfl_xor(p2, 1); p2 += __shfl_xor(p2, 2); p2 += __shfl_xor(p2, 4);
        mx2 = fmaxf(mx2, p2); }
#pragma unroll
    for (int o = 8; o < 64; o <<= 1) mx2 = fmaxf(mx2, __shfl_xor(mx2, o));
    if ((tid & 63) == 0) atomicMax((unsigned*)(lds + KCMAX_OFF), __builtin_bit_cast(unsigned, mx2));
}
constexpr size_t WS_KMAXP = WS_SMALL + 65536;
__device__ __forceinline__ void kmax_item(int item, unsigned char* ws, LAS unsigned char* lds, int tid, int lane, int wave) {
    const int key = item >> 3, part = item & 7, br = key >> 4, bg = key & 15, g = bg & 1, b = bg >> 1;
    const bf16* Kb = (const bf16*)(ws + (br ? WS_KVW : WS_KVS)) + ((size_t)b * SEQ + 512 * part) * 256 + g * 64 + 8 * (lane & 7);
    float mx2 = 0.f;
#pragma unroll
    for (int i = 0; i < 8; ++i) { const int row = 8 * (wave + 8 * i) + (lane >> 3);
        const v4u kq = *(const GAS v4u*)(Kb + (size_t)row * 256);
        float p2 = (bflo(kq.x) * bflo(kq.x) + bfhi(kq.x) * bfhi(kq.x)) + (bflo(kq.y) * bflo(kq.y) + bfhi(kq.y) * bfhi(kq.y)) + (bflo(kq.z) * bflo(kq.z) + bfhi(kq.z) * bfhi(kq.z)) + (bflo(kq.w) * bflo(kq.w) + bfhi(kq.w) * bfhi(kq.w));
        p2 += __shfl_xor(p2, 1); p2 += __shfl_xor(p2, 2); p2 += __shfl_xor(p2, 4);
        mx2 = fmaxf(mx2, p2); }
#pragma unroll
    for (int o = 8; o < 64; o <<= 1) mx2 = fmaxf(mx2, __shfl_xor(mx2, o));
    LAS float* red = (LAS float*)lds;
    if (lane == 0) red[wave] = mx2;
    __syncthreads();
    if (tid == 0) { float m = red[0];
#pragma unroll
        for (int w = 1; w < 8; ++w) m = fmaxf(m, red[w]);
        ((float*)(ws + WS_KMAXP))[item] = m; }
    __syncthreads();
}

__device__ __forceinline__ void nsa_unit(int b, int g, int qb, unsigned char* ws, LAS unsigned char* lds, int tid, int lane, int wave) {
    asm volatile("" : "+v"(tid), "+v"(lane));
    const int r32 = lane & 31, h = lane >> 5, ql = r32 >> 2, hh = r32 & 3;
    const int tl = 8 * wave + ql, t = 64 * qb + tl, hd = g * 4 + hh, bg = b * 2 + g;
    const size_t tok = (size_t)b * SEQ + t;
    bf16x8 qf[4];
#pragma unroll
    for (int ks = 0; ks < 4; ++ks) qf[ks] = ld16g((const bf16*)(ws + WS_QN) + tok * 512 + hd * 64 + 16 * ks + 8 * h);
    float qn = 0.f;
#pragma unroll
    for (int ks = 0; ks < 4; ++ks)
#pragma unroll
        for (int e = 0; e < 8; ++e) { const float v = __builtin_bit_cast(float, ((unsigned)(unsigned short)qf[ks][e]) << 16); qn += v * v; }
    qn += __shfl_xor(qn, 32);
    qn = __builtin_sqrtf(qn) * 1.0001f;
    const float* kmx = (const float*)(ws + WS_KMAXP) + 8 * bg;
    float k2s = kmx[0], k2w = kmx[128];
#pragma unroll
    for (int i = 1; i < 8; ++i) { k2s = fmaxf(k2s, kmx[i]); k2w = fmaxf(k2w, kmx[128 + i]); }
    const float negm_slc = -qn * __builtin_sqrtf(k2s), negm_win = -qn * __builtin_sqrtf(k2w);
    const float negm_cmp = -qn * __builtin_sqrtf(__builtin_bit_cast(float, *(const LAS unsigned*)(lds + KCMAX_OFF)));
    const bf16* NGp = (const bf16*)(ws + WS_NG) + tok * 32 + hd * 3;
    const float g_cmp = bflo((unsigned)NGp[0]), g_slc = bflo((unsigned)NGp[1]), g_win = bflo((unsigned)NGp[2]);
    unsigned outp[2][8];
    unsigned long long selmask = (2ull << qb) - 1ull;
    {
        const int nmaxu = 4 * qb + 2, nlim = t >= 31 ? ((t - 31) >> 4) : -1;
        float l = 0.f, carry = 0.f;
        float xs[8][4];
        f32x16 oc[2], cinit;
#pragma unroll
        for (int r = 0; r < 16; ++r) { oc[0][r] = 0.f; oc[1][r] = 0.f; cinit[r] = negm_cmp; }
#pragma unroll
        for (int mt = 0; mt < 8; ++mt) {
#pragma unroll
            for (int a = 0; a < 4; ++a) xs[mt][a] = 0.f;
            if (32 * mt <= nmaxu) {
                f32x16 a_ = cinit;
#pragma unroll
                for (int ks = 0; ks < 4; ++ks) a_ = mfma32(ld16l(lds + KC_OFF + (32 * mt + r32) * KC_RS + (16 * ks + 8 * h) * 2), qf[ks], a_);
#pragma unroll
                for (int r = 0; r < 16; ++r) { const int nn = 32 * mt + crow(r, h); const float p = nn <= nlim ? fexp2(a_[r]) : 0.f; a_[r] = p; l += p; }
#pragma unroll
                for (int s2 = 0; s2 < 2; ++s2) { const bf16x8 pb = packp(a_, s2);
#pragma unroll
                    for (int md = 0; md < 2; ++md) oc[md] = mfma32(ld16l(lds + VCT_OFF + (32 * md + r32) * VCT_RS + (32 * mt + 16 * s2 + 8 * h) * 2), pb, oc[md]); }
                if (qb >= 16) {
                    float rc[4];
#pragma unroll
                    for (int a = 0; a < 4; ++a) rc[a] = xpartner(a_[4 * a + 3], h);
#pragma unroll
                    for (int a = 0; a < 4; ++a) { const float pv = h ? rc[a] : (a > 0 ? rc[a > 0 ? a - 1 : 0] : carry);
                        xs[mt][a] = ((a_[4 * a] + a_[4 * a + 1]) + (a_[4 * a + 2] + a_[4 * a + 3])) + pv; }
                    carry = rc[3];
                }
            }
        }
        l = xsum(l);
        const float inv = l > 0.f ? 1.f / l : 0.f;
        { const float scl = inv * g_cmp;
#pragma unroll
          for (int r = 0; r < 8; ++r) { outp[0][r] = cvtpk(oc[0][2 * r] * scl, oc[0][2 * r + 1] * scl); outp[1][r] = cvtpk(oc[1][2 * r] * scl, oc[1][2 * r + 1] * scl); } }
        if (qb >= 16) {
            unsigned key[8];
#pragma unroll
            for (int mt = 0; mt < 8; ++mt) {
                float x[4];
#pragma unroll
                for (int a = 0; a < 4; ++a) { x[a] = xs[mt][a] * inv; x[a] += quad_xor1(x[a]); x[a] += quad_xor2(x[a]); }
                const float v = hh == 0 ? x[0] : hh == 1 ? x[1] : hh == 2 ? x[2] : x[3];
                const int J = 8 * mt + 2 * hh + h;
                const bool valid = J <= qb, forced = (J == 0) || (J == qb) || (J == qb - 1);
                const unsigned vb = ((__builtin_bit_cast(unsigned, v) >> 1) | 0x40000000u) & ~63u;
                key[mt] = (!valid ? 0x40u : forced ? 0xC0000000u : vb) | (unsigned)(63 - J);
            }
            selmask = 0ull;
            for (int round = 0; round < 16; ++round) {
                unsigned w = key[0];
#pragma unroll
                for (int i2 = 1; i2 < 8; ++i2) w = w > key[i2] ? w : key[i2];
                unsigned o2 = __builtin_bit_cast(unsigned, quad_xor1(__builtin_bit_cast(float, w))); w = w > o2 ? w : o2;
                o2 = __builtin_bit_cast(unsigned, quad_xor2(__builtin_bit_cast(float, w))); w = w > o2 ? w : o2;
                o2 = (unsigned)__shfl_xor((int)w, 32); w = w > o2 ? w : o2;
                selmask |= 1ull << (63 - (w & 63u));
#pragma unroll
                for (int i2 = 0; i2 < 8; ++i2) key[i2] = key[i2] == w ? 0u : key[i2];
            }
        }
    }
    const bf16* Ksl = (const bf16*)(ws + WS_KVS) + (size_t)b * SEQ * 256 + g * 64;
    const bf16* Kwn = (const bf16*)(ws + WS_KVW) + (size_t)b * SEQ * 256 + g * 64;
    attend<0, true>(outp, qf, negm_slc, Ksl, Ksl + 128, qb, tl, selmask, g_slc, lds, tid, lane, wave);
    attend<1, true>(outp, qf, negm_win, Kwn, Kwn + 128, qb, tl, selmask, g_win, lds, tid, lane, wave);
    bf16* op = (bf16*)(ws + WS_ONSA) + tok * 512 + hd * 64;
#pragma unroll
    for (int md = 0; md < 2; ++md)
#pragma unroll
        for (int a = 0; a < 4; ++a) { v2u ov; ov.x = outp[md][2 * a]; ov.y = outp[md][2 * a + 1];
            *(GAS v2u*)(op + 32 * md + 8 * a + 4 * h) = ov; }
}

#ifndef PHASE_MASK
#define PHASE_MASK 0xffffu
#endif
#ifndef DBL_MASK
#define DBL_MASK 0u
#endif
__global__ void __launch_bounds__(NTHR, 2) mega_fwd(Args args) {
    extern __shared__ __attribute__((aligned(16))) unsigned char lds_raw[];
    LAS unsigned char* lds = (LAS unsigned char*)lds_raw;
    volatile LAS unsigned* MISC = (volatile LAS unsigned*)(lds + MISC_OFF);
    const int tid = threadIdx.x, lane = tid & 63, wave = __builtin_amdgcn_readfirstlane(tid >> 6);
    const int G = gridDim.x; const int vcu = (G % 8 == 0) ? ((int)blockIdx.x % 8) * (G / 8) + (int)blockIdx.x / 8 : (int)blockIdx.x;
    unsigned char* ws = args.ws;
    gu32* ctl = (gu32*)(ws + WS_CTL);
    for (int u = tid; u < (LDS_BYTES - LDSCTL_OFF) / 4; u += NTHR) ((LAS unsigned*)(lds + LDSCTL_OFF))[u] = 0u;
    __syncthreads();
    const int lo = args.ph_lo, hi = args.ph_hi;
    const bool one_launch = (hi - lo) > 1;
    XcdBarrier bar; bar.bar = (unsigned*)(ctl + CW_BAR); bar.x = 0; bar.st = nullptr;
    if (one_launch) bar = xcd_barrier_post((unsigned*)(ctl + CW_BAR), MISC + 8);
#define IN(k) (((PHASE_MASK >> (k)) & 1u) && lo <= (k) && (k) < hi)
#define SEAM(k) do { if (IN(k) && IN((k) + 1)) xcd_barrier(bar); } while (0)
    const int gw = vcu * NWAVES + wave, NGW = G * NWAVES;
    const float* mod = (const float*)(ws + WS_MOD);
    bf16* U = (bf16*)(ws + WS_U); bf16* HACT = (bf16*)(ws + WS_HACT);
    bf16* HS = (bf16*)args.out;

    unsigned long long* SS2 = (unsigned long long*)(ws + WS_SS2); unsigned long long* SS3 = (unsigned long long*)(ws + WS_SS3);
    if (IN(0)) { p0_prologue(args, lds, tid, lane, wave, vcu, G); } SEAM(0);
    if (IN(1)) { cvec_phase(ws, mod, lds, tid, lane, gw, NGW); norm_mod_phase<true>(args.x, args.norm1_w, mod, 0, 1, U, gw, NGW, lane); } SEAM(1);
    if (IN(2)) { pg8::Gemm gm{U, (const bf16*)(ws + WS_W1A), TT, 2 * FF, DM}; pg8::StaticOrder S; S.init(TT, 2 * FF, G, (int)blockIdx.x);
        pg8::EpiSwiglu E{HACT, FF}; pg8::gemm_phase<pg8::EpiSwiglu, pg8::StaticOrder, true, true>(lds, gm, S, E); } SEAM(2);
    if (IN(3)) { pg8::Gemm gm{HACT, (const bf16*)(ws + WS_W1B), TT, DM, FF}; pg8::StaticOrder S; S.init(TT, DM, G, (int)blockIdx.x);
        pg8::EpiResid<true, true> E{args.x, HS, mod + 2 * 1024, U, args.norm2_w, mod + 4 * 1024, SS2, 0.5f}; pg8::gemm_phase<pg8::EpiResid<true, true>, pg8::StaticOrder, true, true>(lds, gm, S, E); } SEAM(3);
    if (IN(4)) { pg8::Gemm gm{U, (const bf16*)(ws + WS_WIN), TT, NPROJ, DM}; pg8::StaticOrder S; S.init(TT, NPROJ, G, (int)blockIdx.x);
        pg8::EpiInProj E{(bf16*)(ws + WS_QN), (bf16*)(ws + WS_KVC), (bf16*)(ws + WS_KVS), (bf16*)(ws + WS_KVW), (bf16*)(ws + WS_RQ), (bf16*)(ws + WS_RK), (bf16*)(ws + WS_RV), (bf16*)(ws + WS_RG),
                         (bf16*)(ws + WS_GA), (bf16*)(ws + WS_GB), (bf16*)(ws + WS_NG), (const float*)(ws + WS_COS), (const float*)(ws + WS_SIN), QSCALE, SS2, (const float*)(ws + WS_CV2)};
        pg8::gemm_phase<pg8::EpiInProj, pg8::StaticOrder, true, true>(lds, gm, S, E); } SEAM(4);
    if (IN(5)) {
        for (int u = vcu; u < 256; u += G) compress_unit(u, ws, lds, lane, wave);
        for (int grp = vcu; grp < 256; grp += G) {
            f32x4 run[2] = {{0.f, 0.f, 0.f, 0.f}, {0.f, 0.f, 0.f, 0.f}};
            ChunkRegs nx = load_chunk(8 * grp, ws, tid);
            for (int i = 0; i < 8; ++i) { const ChunkRegs cr = nx; if (i < 7) nx = load_chunk(8 * grp + i + 1, ws, tid);
                sloc_unit(8 * grp + i, cr, ws, lds, tid, lane, wave, run, i == 7); } }
        for (int it = vcu; it < 256; it += G) kmax_item(it, ws, lds, tid, lane, wave);
    } SEAM(5);
    if (IN(6)) {
        int cur_bg = -1;
        for (int Uu = vcu; Uu < 1024; Uu += G) { const int bg = (Uu & 255) >> 4, sidx = Uu & 15, k = Uu >> 8;
            const int qb = k == 0 ? sidx : k == 1 ? 31 - sidx : k == 2 ? 32 + sidx : 63 - sidx;
            if (bg != cur_bg) { __syncthreads(); load_cmp_images(bg, ws, lds, tid); __syncthreads(); cur_bg = bg; }
            nsa_unit(bg >> 1, bg & 1, qb, ws, lds, tid, lane, wave); }
        __syncthreads();
    }
    if (IN(7)) {
        if (vcu < 2048) { ChunkRegs nx = load_chunk(vcu, ws, tid);
            for (int u = vcu; u < 2048; u += G) { const ChunkRegs cr = nx; if (u + G < 2048) nx = load_chunk(u + G, ws, tid);
                ret_unit(u, cr, ws, args.ret_norm_w, lds, tid, lane, wave); } }
    } SEAM(7);
    if (IN(8)) {
        { pg8::Gemm gm{(const bf16*)(ws + WS_ONSA), (const bf16*)(ws + WS_WNU), TT, DM, 512}; pg8::StaticOrder S; S.init(TT, DM, G, (int)blockIdx.x);
          pg8::EpiMix<false> E{(const bf16*)(ws + WS_GA), (bf16*)(ws + WS_MIXED)}; pg8::gemm_phase<pg8::EpiMix<false>, pg8::StaticOrder, true, true>(lds, gm, S, E); }
        { pg8::Gemm gm{(const bf16*)(ws + WS_ORET), (const bf16*)(ws + WS_WRU), TT, DM, 512}; pg8::StaticOrder S; S.init(TT, DM, G, (int)blockIdx.x);
          pg8::EpiMix<true> E{(const bf16*)(ws + WS_GB), (bf16*)(ws + WS_MIXED)}; pg8::gemm_phase<pg8::EpiMix<true>, pg8::StaticOrder, true, true>(lds, gm, S, E); }
    } SEAM(8);
    if (IN(9)) { pg8::Gemm gm{(const bf16*)(ws + WS_MIXED), (const bf16*)(ws + WS_WO), TT, DM, DM}; pg8::StaticOrder S; S.init(TT, DM, G, (int)blockIdx.x);
        pg8::EpiResid<false, true> E{HS, HS, mod + 5 * 1024, U, args.norm3_w, mod + 7 * 1024, SS3, 1.0f}; pg8::gemm_phase<pg8::EpiResid<false, true>, pg8::StaticOrder, true, true>(lds, gm, S, E); } SEAM(9);
    if (IN(10)) { pg8::Gemm gm{U, (const bf16*)(ws + WS_W2A), TT, 2 * FF, DM}; pg8::StaticOrder S; S.init(TT, 2 * FF, G, (int)blockIdx.x);
        pg8::EpiSwiglu8 E{(unsigned char*)HACT, FF, SS3, (const float*)(ws + WS_CV3)}; pg8::gemm_phase<pg8::EpiSwiglu8, pg8::StaticOrder, true, true>(lds, gm, S, E); } SEAM(10);
    if (IN(11)) { pg8::Gemm gm{HACT, (const bf16*)(ws + WS_W2B), TT, DM, FF / 2};   pg8::StaticOrder S; S.init(TT, DM, G, (int)blockIdx.x);
        pg8::EpiResid<false, false> E{HS, (bf16*)(ws + WS_H3), mod + 8 * 1024, nullptr, nullptr, nullptr, nullptr, 0.5f}; pg8::gemm_phase<pg8::EpiResid<false, false>, pg8::StaticOrder, true, true, true>(lds, gm, S, E); } SEAM(11);
    if (IN(12)) { final_norm_phase((const bf16*)(ws + WS_H3), args.out, args.final_norm_w, gw, NGW, lane); }
#undef IN
#undef SEAM
}

#ifndef N_LAUNCHES
#define N_LAUNCHES 1
#endif
constexpr int N_PHASES = 13;

extern "C" void kernel_launch(void* const* d_in, const int* in_sizes, int n_in, void* d_out, int out_size, void* d_ws, size_t ws_size, hipStream_t stream) {
    static int grid = 0;
    if (grid == 0) {
        if (n_in != 23 || in_sizes[0] != TT * DM || out_size != TT * DM || ws_size < WS_END) { fprintf(stderr, "kernel_launch: unexpected shapes (n_in %d, in0 %d, out %d, ws %zu)\n", n_in, n_in > 0 ? in_sizes[0] : -1, out_size, ws_size); grid = -1; return; }
        int dev = 0, cus = 0, per_cu = 0;
        if (hipGetDevice(&dev) != hipSuccess || hipDeviceGetAttribute(&cus, hipDeviceAttributeMultiprocessorCount, dev) != hipSuccess) { grid = -1; return; }
        if (hipFuncSetAttribute((const void*)mega_fwd, hipFuncAttributeMaxDynamicSharedMemorySize, LDS_BYTES) != hipSuccess) { fprintf(stderr, "kernel_launch: hipFuncSetAttribute failed\n"); grid = -1; return; }
        if (hipOccupancyMaxActiveBlocksPerMultiprocessor(&per_cu, (const void*)mega_fwd, NTHR, LDS_BYTES) != hipSuccess || per_cu < 1) { fprintf(stderr, "kernel_launch: occupancy query reports %d blocks per CU\n", per_cu); (void)hipGetLastError(); per_cu = 1; }
        grid = cus;
    }
    if (grid < 0) return;
    (void)hipMemsetAsync((char*)d_ws + WS_CTL, 0, CTL_ZERO_BYTES, stream);
    Args a{};
    const float** ap = (const float**)&a;
    for (int i = 0; i < 23; ++i) ap[i] = (const float*)d_in[i];
    a.out = (float*)d_out; a.ws = (unsigned char*)d_ws;
    if (N_LAUNCHES == 1) { a.ph_lo = 0; a.ph_hi = N_PHASES; hipLaunchKernelGGL(mega_fwd, dim3(grid), dim3(NTHR), LDS_BYTES, stream, a); }
    else for (int p = 0; p < N_PHASES; ++p) { a.ph_lo = p; a.ph_hi = p + 1; for (int rep = 0; rep < 1 + (int)((DBL_MASK >> p) & 1u); ++rep) hipLaunchKernelGGL(mega_fwd, dim3(grid), dim3(NTHR), LDS_BYTES, stream, a); }
}
```

```cpp
#include <hip/hip_runtime.h>
#include <cstdio>
#include <cstdint>
namespace pg8 {
#define PG8_LAS __attribute__((address_space(3)))
typedef unsigned short bf16_t;
typedef short bf16x8 __attribute__((ext_vector_type(8)));
typedef float f32x4 __attribute__((ext_vector_type(4)));
typedef unsigned u32x4 __attribute__((ext_vector_type(4)));
typedef int v4i_t __attribute__((ext_vector_type(4)));
constexpr int BM = 256, BK = 64, HALF = 128, HTB = HALF * BK * 2  , STAGE_BYTES = 8 * HTB, NXCD = 8, WGM = 4;

__host__ __device__ __forceinline__ int lds_byte(int r, int c) { const int st = (r >> 4) * 2 + (c >> 5), rr = r & 15, cc = c & 31, ob = rr * 64 + cc * 2; return st * 1024 + (ob ^ (((ob >> 9) & 1) << 5)); }
__host__ __device__ __forceinline__ void stage_rc(int b, int& R, int& C) { const int st = b / 1024, sb = b % 1024, swz = sb ^ (((sb >> 9) & 1) << 5); R = (st >> 1) * 16 + swz / 64; C = (st & 1) * 32 + (swz % 64) / 2; }
__host__ __device__ __forceinline__ int perm32(int rho) { const int n = rho >> 4, i = rho & 15; return 8 * (i >> 2) + 4 * n + (i & 3); }

struct Unit { int pm, pn; };
struct Gemm { const bf16_t* A; const bf16_t* Bt; int M, N, K; };

struct StaticOrder {
    int nM, nN, nwg, G, c;
    __host__ __device__ void init(int M, int N, int G_, int c_) { nM = M / BM; nN = N / BM; nwg = nM * nN; G = G_; c = c_; }
    __host__ __device__ bool next(int i, Unit& u) const {
        const long L = (long)i * G + c; if (L >= nwg) return false;
        int wgid = (int)L; { const int q = nwg / NXCD, r = nwg % NXCD, xcd = wgid % NXCD, off = wgid / NXCD; wgid = (xcd < r ? xcd * (q + 1) : r * (q + 1) + (xcd - r) * q) + off; }
        const int nig = WGM * nN, gid = wgid / nig, fm = gid * WGM, gsz = (nM - fm) < WGM ? (nM - fm) : WGM;
        u.pm = fm + ((wgid % nig) % gsz); u.pn = (wgid % nig) / gsz; return true;
    }
    __device__ __forceinline__ void a_ready(const Unit&) const {}
    __device__ __forceinline__ void done(const Unit&) const {}
};

__device__ __forceinline__ unsigned cvt_pk_bf16(float lo, float hi) { unsigned r; asm volatile("v_cvt_pk_bf16_f32 %0, %1, %2" : "=v"(r) : "v"(lo), "v"(hi)); return r; }
typedef unsigned u32x2 __attribute__((ext_vector_type(2)));
__device__ __forceinline__ float fsigm(float x) { return __builtin_amdgcn_rcpf(1.f + __builtin_amdgcn_exp2f(-1.4426950408889634f * x)); }
__device__ __forceinline__ float fsilu(float x) { return x * fsigm(x); }
__device__ __forceinline__ float bflo(unsigned w) { return __builtin_bit_cast(float, w << 16); }
__device__ __forceinline__ float bfhi(unsigned w) { return __builtin_bit_cast(float, w & 0xffff0000u); }

__device__ __forceinline__ u32x2 pk8_fp8(const f32x4& a, const f32x4& b) {
    u32x2 r; int w = 0;
    w = __builtin_amdgcn_cvt_pk_fp8_f32(__builtin_amdgcn_fmed3f(a[0], -448.f, 448.f), __builtin_amdgcn_fmed3f(a[1], -448.f, 448.f), w, false);
    w = __builtin_amdgcn_cvt_pk_fp8_f32(__builtin_amdgcn_fmed3f(a[2], -448.f, 448.f), __builtin_amdgcn_fmed3f(a[3], -448.f, 448.f), w, true); r.x = (unsigned)w; w = 0;
    w = __builtin_amdgcn_cvt_pk_fp8_f32(__builtin_amdgcn_fmed3f(b[0], -448.f, 448.f), __builtin_amdgcn_fmed3f(b[1], -448.f, 448.f), w, false);
    w = __builtin_amdgcn_cvt_pk_fp8_f32(__builtin_amdgcn_fmed3f(b[2], -448.f, 448.f), __builtin_amdgcn_fmed3f(b[3], -448.f, 448.f), w, true); r.y = (unsigned)w;
    return r;
}
__device__ __forceinline__ float rstd_of(const unsigned long long* SS, int row) { return __builtin_amdgcn_rsqf((float)SS[row] * (1.0f / (1048576.0f * 1024.0f)) + 1e-6f); }
struct EpiSwiglu8 {
    static constexpr bool PERM = true, AFTER_DRAIN = false;
    unsigned char* O; int ldc; const unsigned long long* SS; const float* CV;
    __device__ __forceinline__ void operator()(const f32x4 (&acc)[2][2][4][2], const Unit& u, int wr, int wc, int fr, int fq) const {
        const int row0 = u.pm * BM + wr * 64 + fr, col0 = u.pn * HALF + wc * 32 + 8 * fq;
        const float* cp = CV + (size_t)((u.pm * BM) >> 12) * (2 * 2816) + u.pn * BM + wc * 32 + 8 * fq;
        const f32x4 ca0 = *(const f32x4*)cp, ca1 = *(const f32x4*)(cp + 4), cb0 = *(const f32x4*)(cp + HALF), cb1 = *(const f32x4*)(cp + HALF + 4);
        float rsv[2][4];
#pragma unroll
        for (int ai = 0; ai < 2; ++ai)
#pragma unroll
            for (int m = 0; m < 4; ++m) rsv[ai][m] = rstd_of(SS, row0 + ai * HALF + m * 16);
#pragma unroll
        for (int ai = 0; ai < 2; ++ai)
#pragma unroll
            for (int m = 0; m < 4; ++m) {
                const int row = row0 + ai * HALF + m * 16;
                unsigned char* rowp = O + (size_t)row * ldc + col0;
                const float rs = rsv[ai][m];
                const f32x4 a0 = acc[ai][0][m][0] * rs + ca0, a1 = acc[ai][0][m][1] * rs + ca1, b0 = acc[ai][1][m][0] * rs + cb0, b1 = acc[ai][1][m][1] * rs + cb1;
                f32x4 h0, h1;
#pragma unroll
                for (int j = 0; j < 4; ++j) { h0[j] = fsilu(a0[j]) * b0[j]; h1[j] = fsilu(a1[j]) * b1[j]; }
                *(u32x2*)rowp = pk8_fp8(h0, h1);
            }
    }
};
struct EpiSwiglu {
    static constexpr bool PERM = true, AFTER_DRAIN = false;
    bf16_t* O; int ldc;
    __device__ __forceinline__ void operator()(const f32x4 (&acc)[2][2][4][2], const Unit& u, int wr, int wc, int fr, int fq) const {
        const int row0 = u.pm * BM + wr * 64 + fr, col0 = u.pn * HALF + wc * 32 + 8 * fq;
#pragma unroll
        for (int ai = 0; ai < 2; ++ai)
#pragma unroll
            for (int m = 0; m < 4; ++m) {
                bf16_t* rowp = O + (size_t)(row0 + ai * HALF + m * 16) * ldc + col0;
                const f32x4 a0 = acc[ai][0][m][0], a1 = acc[ai][0][m][1], b0 = acc[ai][1][m][0], b1 = acc[ai][1][m][1];
                u32x4 w;
                w.x = cvt_pk_bf16(fsilu(a0[0]) * b0[0], fsilu(a0[1]) * b0[1]); w.y = cvt_pk_bf16(fsilu(a0[2]) * b0[2], fsilu(a0[3]) * b0[3]);
                w.z = cvt_pk_bf16(fsilu(a1[0]) * b1[0], fsilu(a1[1]) * b1[1]); w.w = cvt_pk_bf16(fsilu(a1[2]) * b1[2], fsilu(a1[3]) * b1[3]);
                *(u32x4*)rowp = w;
            }
    }
};

template <bool RF32, bool NOUT> struct EpiResid {
    static constexpr bool PERM = true, AFTER_DRAIN = false;
    const void* R; bf16_t* C; const float* gate; bf16_t* V; const float* nw; const float* scm; unsigned long long* SS; float scale;
    __device__ __forceinline__ void operator()(const f32x4 (&acc)[2][2][4][2], const Unit& u, int wr, int wc, int fr, int fq) const {
        const int row0 = u.pm * BM + wr * 64 + fr, col0 = u.pn * BM + wc * 32 + 8 * fq;
        const size_t boff = (size_t)((u.pm * BM) >> 12) * 9216 + col0;
        f32x4 gv[2][2], g2[2][2]; f32x4 ssv[2] = {{0.f, 0.f, 0.f, 0.f}, {0.f, 0.f, 0.f, 0.f}};
#pragma unroll
        for (int bj = 0; bj < 2; ++bj)
#pragma unroll
            for (int n = 0; n < 2; ++n) { gv[bj][n] = *(const f32x4*)(gate + boff + bj * HALF + n * 4) * scale;
                if (NOUT) g2[bj][n] = *(const f32x4*)(nw + col0 + bj * HALF + n * 4) * (*(const f32x4*)(scm + boff + bj * HALF + n * 4) + 1.f); }
#pragma unroll
        for (int ai = 0; ai < 2; ++ai)
#pragma unroll
            for (int m = 0; m < 4; ++m) {
                const int row = row0 + ai * HALF + m * 16;
                const size_t ro = (size_t)row * 1024 + col0;
                float ssq = 0.f;
#pragma unroll
                for (int bj = 0; bj < 2; ++bj) {
                    f32x4 r0, r1;
                    if (RF32) { r0 = *(const f32x4*)((const float*)R + ro + bj * HALF); r1 = *(const f32x4*)((const float*)R + ro + bj * HALF + 4); }
                    else { const u32x4 w = *(const u32x4*)((const bf16_t*)R + ro + bj * HALF);
                        r0 = (f32x4){bflo(w.x), bfhi(w.x), bflo(w.y), bfhi(w.y)}; r1 = (f32x4){bflo(w.z), bfhi(w.z), bflo(w.w), bfhi(w.w)}; }
                    const f32x4 v0 = r0 + gv[bj][0] * acc[ai][bj][m][0], v1 = r1 + gv[bj][1] * acc[ai][bj][m][1];
                    u32x4 o; o.x = cvt_pk_bf16(v0[0], v0[1]); o.y = cvt_pk_bf16(v0[2], v0[3]); o.z = cvt_pk_bf16(v1[0], v1[1]); o.w = cvt_pk_bf16(v1[2], v1[3]);
                    *(u32x4*)(C + ro + bj * HALF) = o;
                    if (NOUT) {
                        ssq += ((v0[0] * v0[0] + v0[1] * v0[1]) + (v0[2] * v0[2] + v0[3] * v0[3])) + ((v1[0] * v1[0] + v1[1] * v1[1]) + (v1[2] * v1[2] + v1[3] * v1[3]));
                        const f32x4 y0 = v0 * g2[bj][0], y1 = v1 * g2[bj][1];
                        u32x4 p; p.x = cvt_pk_bf16(y0[0], y0[1]); p.y = cvt_pk_bf16(y0[2], y0[3]); p.z = cvt_pk_bf16(y1[0], y1[1]); p.w = cvt_pk_bf16(y1[2], y1[3]);
                        *(u32x4*)(V + ro + bj * HALF) = p;
                    }
                }
                if (NOUT) ssv[ai][m] = ssq;
            }
        if (NOUT) {
#pragma unroll
            for (int ai = 0; ai < 2; ++ai)
#pragma unroll
                for (int m = 0; m < 4; ++m) { float t = ssv[ai][m]; t += __shfl_xor(t, 16); t += __shfl_xor(t, 32); ssv[ai][m] = t; }
            if (fq == 0) {
#pragma unroll
                for (int ai = 0; ai < 2; ++ai)
#pragma unroll
                    for (int m = 0; m < 4; ++m)
                        (void)__hip_atomic_fetch_add(SS + row0 + ai * HALF + m * 16, (unsigned long long)(ssv[ai][m] * 1048576.0f), __ATOMIC_RELAXED, __HIP_MEMORY_SCOPE_AGENT);
            }
        }
    }
};

struct EpiInProj {
    static constexpr bool PERM = true, AFTER_DRAIN = false;
    bf16_t *QN, *KVC, *KVS, *KVW, *RQ, *RK, *RV, *RG, *GA, *GB, *NG; const float *COS, *SIN; float qscale;
    const unsigned long long* SS; const float* CV;
    __device__ __forceinline__ void operator()(const f32x4 (&acc)[2][2][4][2], const Unit& u, int wr, int wc, int fr, int fq) const {
        const int pn = u.pn;
        bf16_t* base; int ldc, colt, mode; float sc = 1.f;
        if (pn < 2)       { base = QN;  ldc = 512;  colt = pn * 256;        mode = 0; sc = qscale; }
        else if (pn == 2) { base = KVC; ldc = 256;  colt = 0;               mode = 0; }
        else if (pn == 3) { base = KVS; ldc = 256;  colt = 0;               mode = 0; }
        else if (pn == 4) { base = KVW; ldc = 256;  colt = 0;               mode = 0; }
        else if (pn < 7)  { base = RQ;  ldc = 512;  colt = (pn - 5) * 256;  mode = 1; }
        else if (pn < 9)  { base = RK;  ldc = 512;  colt = (pn - 7) * 256;  mode = 1; sc = 0.125f; }
        else if (pn < 11) { base = RV;  ldc = 512;  colt = (pn - 9) * 256;  mode = 0; }
        else if (pn < 13) { base = RG;  ldc = 512;  colt = (pn - 11) * 256; mode = 2; }
        else if (pn < 17) { base = GA;  ldc = 1024; colt = (pn - 13) * 256; mode = 3; }
        else if (pn < 21) { base = GB;  ldc = 1024; colt = (pn - 17) * 256; mode = 3; }
        else              { base = NG;  ldc = 32;   colt = 0;               mode = 4; }
        const int row0 = u.pm * BM + wr * 64 + fr, col0 = colt + wc * 32 + 8 * fq;
        const int i0 = (wc & 1) * 16 + 4 * fq;
        const float* cp = CV + (size_t)((u.pm * BM) >> 12) * 5632 + pn * BM + wc * 32 + 8 * fq;
        f32x4 cv[2][2];
#pragma unroll
        for (int bj = 0; bj < 2; ++bj) { cv[bj][0] = *(const f32x4*)(cp + bj * HALF); cv[bj][1] = *(const f32x4*)(cp + bj * HALF + 4); }
        float rsv[2][4];
#pragma unroll
        for (int ai = 0; ai < 2; ++ai)
#pragma unroll
            for (int m = 0; m < 4; ++m) rsv[ai][m] = rstd_of(SS, row0 + ai * HALF + m * 16);
#pragma unroll
        for (int ai = 0; ai < 2; ++ai)
#pragma unroll
            for (int m = 0; m < 4; ++m) {
                const int row = row0 + ai * HALF + m * 16;
                bf16_t* rowp = base + (size_t)row * ldc + col0;
                const float rs = rsv[ai][m];
                f32x4 c4 = {1.f, 1.f, 1.f, 1.f}, s4 = {0.f, 0.f, 0.f, 0.f};
                if (mode == 1) { c4 = *(const f32x4*)(COS + (size_t)(row & 4095) * 32 + i0); s4 = *(const f32x4*)(SIN + (size_t)(row & 4095) * 32 + i0); }
#pragma unroll
                for (int bj = 0; bj < 2; ++bj) {
                    f32x4 v0 = acc[ai][bj][m][0] * rs + cv[bj][0], v1 = acc[ai][bj][m][1] * rs + cv[bj][1];
                    if (mode == 0) { v0 = v0 * sc; v1 = v1 * sc; }
                    else if (mode == 1) {
                        f32x4 o0, o1;
                        o0[0] = (v0[0] * c4[0] - v0[1] * s4[0]) * sc; o0[1] = (v0[0] * s4[0] + v0[1] * c4[0]) * sc;
                        o0[2] = (v0[2] * c4[1] - v0[3] * s4[1]) * sc; o0[3] = (v0[2] * s4[1] + v0[3] * c4[1]) * sc;
                        o1[0] = (v1[0] * c4[2] - v1[1] * s4[2]) * sc; o1[1] = (v1[0] * s4[2] + v1[1] * c4[2]) * sc;
                        o1[2] = (v1[2] * c4[3] - v1[3] * s4[3]) * sc; o1[3] = (v1[2] * s4[3] + v1[3] * c4[3]) * sc;
                        v0 = o0; v1 = o1;
                    } else if (mode == 2) {
#pragma unroll
                        for (int j = 0; j < 4; ++j) { v0[j] = fsilu(v0[j]); v1[j] = fsilu(v1[j]); }
                    } else {
#pragma unroll
                        for (int j = 0; j < 4; ++j) { v0[j] = fsigm(v0[j]); v1[j] = fsigm(v1[j]); }
                    }
                    u32x4 w; w.x = cvt_pk_bf16(v0[0], v0[1]); w.y = cvt_pk_bf16(v0[2], v0[3]); w.z = cvt_pk_bf16(v1[0], v1[1]); w.w = cvt_pk_bf16(v1[2], v1[3]);
                    if (mode != 4) *(u32x4*)(rowp + bj * HALF) = w;
                    else if (bj == 0 && wc == 0) *(u32x4*)rowp = w;
                }
            }
    }
};

template <bool ADD> struct EpiMix {
    static constexpr bool PERM = true, AFTER_DRAIN = false;
    const bf16_t* Gt; bf16_t* O;
    __device__ __forceinline__ void operator()(const f32x4 (&acc)[2][2][4][2], const Unit& u, int wr, int wc, int fr, int fq) const {
        const int row0 = u.pm * BM + wr * 64 + fr, col0 = u.pn * BM + wc * 32 + 8 * fq;
#pragma unroll
        for (int ai = 0; ai < 2; ++ai)
#pragma unroll
            for (int m = 0; m < 4; ++m) {
                const size_t ro = (size_t)(row0 + ai * HALF + m * 16) * 1024 + col0;
#pragma unroll
                for (int bj = 0; bj < 2; ++bj) {
                    const u32x4 g = *(const u32x4*)(Gt + ro + bj * HALF);
                    f32x4 v0 = acc[ai][bj][m][0], v1 = acc[ai][bj][m][1];
                    v0[0] *= bflo(g.x); v0[1] *= bfhi(g.x); v0[2] *= bflo(g.y); v0[3] *= bfhi(g.y);
                    v1[0] *= bflo(g.z); v1[1] *= bfhi(g.z); v1[2] *= bflo(g.w); v1[3] *= bfhi(g.w);
                    if (ADD) { const u32x4 p = *(const u32x4*)(O + ro + bj * HALF);
                        v0[0] += bflo(p.x); v0[1] += bfhi(p.x); v0[2] += bflo(p.y); v0[3] += bfhi(p.y);
                        v1[0] += bflo(p.z); v1[1] += bfhi(p.z); v1[2] += bflo(p.w); v1[3] += bfhi(p.w); }
                    u32x4 w; w.x = cvt_pk_bf16(v0[0], v0[1]); w.y = cvt_pk_bf16(v0[2], v0[3]); w.z = cvt_pk_bf16(v1[0], v1[1]); w.w = cvt_pk_bf16(v1[2], v1[3]);
                    *(u32x4*)(O + ro + bj * HALF) = w;
                }
            }
    }
};

template <class Epi, class Sched, bool ALIGN_EPI = false, bool SP2 = false, bool FP8 = false>
__device__ __forceinline__ void gemm_phase(PG8_LAS unsigned char* lds, const Gemm g, const Sched& S, const Epi& E) {
    const int tid = threadIdx.x, wid = __builtin_amdgcn_readfirstlane(tid >> 6), lane = tid & 63, wr = wid >> 2, wc = wid & 3, fr = lane & 15, fq = lane >> 4;
    const int K = g.K, nt = K / BK;
    unsigned voffA[2], voffB[2];
#pragma unroll
    for (int i = 0; i < 2; ++i) { int R, C; stage_rc(tid * 16 + i * 8192, R, C); const int Rb = Epi::PERM ? ((R & ~31) + perm32(R & 31)) : R;
        voffA[i] = (unsigned)(R * K + C) * 2u; voffB[i] = (unsigned)(Rb * K + C) * 2u; }
    const size_t kstep = (size_t)(BK * 2);
    const size_t hstep = (size_t)HALF * K * 2;
    const size_t tstep = 2 * hstep;
    const unsigned ldsw = (unsigned)wid * 1024u;
    const int aoff = lds_byte(wr * 64 + fr, fq * 8), boff = lds_byte(wc * 32 + fr, fq * 8);
#define PG8_SA(b, h) (((b) * 2 + (h)) * HTB)
#define PG8_SB(b, h) ((4 + (b) * 2 + (h)) * HTB)
#define PG8_STAGE(bufoff, gbase, voff) do { _Pragma("unroll") for (int _i = 0; _i < 2; ++_i) \
        __builtin_amdgcn_global_load_lds((const unsigned*)((const char*)(gbase) + (voff)[_i]), (PG8_LAS unsigned*)(lds + (bufoff) + ldsw + _i * 8192), 16, 0, 0); } while (0)
#define PG8_LDA(dst, b, h) do { _Pragma("unroll") for (int m = 0; m < 4; ++m) _Pragma("unroll") for (int k = 0; k < 2; ++k) dst[m][k] = *(const PG8_LAS bf16x8*)(lds + PG8_SA(b, h) + aoff + m * 2048 + k * 1024); } while (0)
#define PG8_LDB(dst, b, h) do { _Pragma("unroll") for (int n = 0; n < 2; ++n) _Pragma("unroll") for (int k = 0; k < 2; ++k) dst[n][k] = *(const PG8_LAS bf16x8*)(lds + PG8_SB(b, h) + boff + n * 2048 + k * 1024); } while (0)
#define PG8_CAT8(lo, hi) __builtin_shufflevector(__builtin_bit_cast(v4i_t, lo), __builtin_bit_cast(v4i_t, hi), 0, 1, 2, 3, 4, 5, 6, 7)
#define PG8_MMA(ai, bj, At, Bt) do { __builtin_amdgcn_s_setprio(1); _Pragma("unroll") for (int m = 0; m < 4; ++m) _Pragma("unroll") for (int n = 0; n < 2; ++n) { \
        if constexpr (FP8) { asm volatile("v_mfma_scale_f32_16x16x128_f8f6f4 %0, %1, %2, %0, %3, %4 op_sel_hi:[0,0,0]" : "+v"(acc[ai][bj][m][n]) : "v"(PG8_CAT8(Bt[n][0], Bt[n][1])), "v"(PG8_CAT8(At[m][0], At[m][1])), "v"(fp8_sw), "v"(fp8_sa)); } \
        else { _Pragma("unroll") for (int k = 0; k < 2; ++k) acc[ai][bj][m][n] = __builtin_amdgcn_mfma_f32_16x16x32_bf16(Bt[n][k], At[m][k], acc[ai][bj][m][n], 0, 0, 0); } } \
        __builtin_amdgcn_s_setprio(0); } while (0)
#define PG8_WAIT_V(n) asm volatile("s_waitcnt vmcnt(" #n ")" ::: "memory")
#define PG8_WAIT_L(n) asm volatile("s_waitcnt lgkmcnt(" #n ")" ::: "memory")
#define PG8_BAR __builtin_amdgcn_s_barrier()
#define PG8_SCHED __builtin_amdgcn_sched_barrier(0)
    int fp8_sw = 0x79797979, fp8_sa = 0x7f7f7f7f; (void)fp8_sw; (void)fp8_sa;
    Unit cur, nxt; int ui = 0;
    if (!S.next(0, cur)) return;
    f32x4 acc[2][2][4][2];
#pragma unroll
    for (int a = 0; a < 2; ++a)
#pragma unroll
        for (int b = 0; b < 2; ++b)
#pragma unroll
            for (int m = 0; m < 4; ++m)
#pragma unroll
                for (int n = 0; n < 2; ++n) acc[a][b][m][n] = (f32x4){0.f, 0.f, 0.f, 0.f};
    bf16x8 At[4][2], B0[2][2], B1[2][2];
    const char* cA = (const char*)g.A + (size_t)cur.pm * tstep; const char* cB = (const char*)g.Bt + (size_t)cur.pn * tstep;
    S.a_ready(cur);
    if constexpr (SP2) {
        PG8_STAGE(PG8_SB(0, 0), cB, voffB); PG8_STAGE(PG8_SB(0, 1), cB + hstep, voffB); PG8_STAGE(PG8_SA(0, 0), cA, voffA); PG8_STAGE(PG8_SA(0, 1), cA + hstep, voffA);
        if (wr == 1) PG8_BAR;
        PG8_WAIT_V(2); PG8_BAR;
        PG8_STAGE(PG8_SB(1, 0), cB + kstep, voffB); PG8_STAGE(PG8_SA(1, 0), cA + kstep, voffA); PG8_STAGE(PG8_SB(1, 1), cB + hstep + kstep, voffB);
        PG8_WAIT_V(6); PG8_BAR;
    } else {
        PG8_STAGE(PG8_SB(0, 0), cB, voffB); PG8_STAGE(PG8_SA(0, 0), cA, voffA); PG8_STAGE(PG8_SB(0, 1), cB + hstep, voffB); PG8_STAGE(PG8_SA(0, 1), cA + hstep, voffA);
        if (wr == 1) PG8_BAR;
        PG8_WAIT_V(4); PG8_BAR;
        PG8_STAGE(PG8_SB(1, 0), cB + kstep, voffB); PG8_STAGE(PG8_SA(1, 0), cA + kstep, voffA); PG8_STAGE(PG8_SB(1, 1), cB + hstep + kstep, voffB);
        PG8_WAIT_V(6); PG8_BAR;
    }
    for (;;) {
        const bool has_next = S.next(ui + 1, nxt);
        const char* nA = has_next ? (const char*)g.A + (size_t)nxt.pm * tstep : cA; const char* nB = has_next ? (const char*)g.Bt + (size_t)nxt.pn * tstep : cB;
        for (int t = 0; t < nt; t += 2) {
            const bool last = (t == nt - 2);
            const char* a1 = cA + (size_t)(t + 1) * kstep;
            const char* a2 = last ? nA : cA + (size_t)(t + 2) * kstep; const char* b2 = last ? nB : cB + (size_t)(t + 2) * kstep;
            const char* a3 = a2 + kstep; const char* b3 = b2 + kstep;
            if (last && has_next) S.a_ready(nxt);
            if constexpr (SP2) {
            PG8_LDB(B0, 0, 0); PG8_LDB(B1, 0, 1); PG8_SCHED; PG8_LDA(At, 0, 0); PG8_STAGE(PG8_SA(1, 1), a1 + hstep, voffA);
            PG8_WAIT_V(8); PG8_WAIT_L(0); PG8_BAR; PG8_MMA(0, 0, At, B0); PG8_MMA(0, 1, At, B1); PG8_BAR; PG8_SCHED;
            PG8_LDA(At, 0, 1); PG8_STAGE(PG8_SB(0, 0), b2, voffB); PG8_STAGE(PG8_SB(0, 1), b2 + hstep, voffB); PG8_STAGE(PG8_SA(0, 0), a2, voffA);
            PG8_WAIT_V(8); PG8_WAIT_L(0); PG8_BAR; PG8_MMA(1, 0, At, B0); PG8_MMA(1, 1, At, B1); PG8_BAR; PG8_SCHED;
            PG8_LDB(B0, 1, 0); PG8_LDB(B1, 1, 1); PG8_SCHED; PG8_LDA(At, 1, 0); PG8_STAGE(PG8_SA(0, 1), a2 + hstep, voffA);
            PG8_WAIT_V(8); PG8_WAIT_L(0); PG8_BAR; PG8_MMA(0, 0, At, B0); PG8_MMA(0, 1, At, B1); PG8_BAR; PG8_SCHED;
            PG8_LDA(At, 1, 1); PG8_STAGE(PG8_SB(1, 0), b3, voffB); PG8_STAGE(PG8_SB(1, 1), b3 + hstep, voffB); PG8_STAGE(PG8_SA(1, 0), a3, voffA);
            PG8_WAIT_V(8); PG8_WAIT_L(0); PG8_BAR; PG8_MMA(1, 0, At, B0); PG8_MMA(1, 1, At, B1); PG8_BAR; PG8_SCHED;
            } else {
            PG8_LDB(B0, 0, 0); PG8_SCHED; PG8_LDA(At, 0, 0); PG8_STAGE(PG8_SA(1, 1), a1 + hstep, voffA);
            PG8_WAIT_L(8); PG8_BAR; PG8_WAIT_L(0); PG8_MMA(0, 0, At, B0); PG8_BAR; PG8_SCHED;
            PG8_LDB(B1, 0, 1); PG8_STAGE(PG8_SB(0, 0), b2, voffB);
            PG8_BAR; PG8_WAIT_L(0); PG8_MMA(0, 1, At, B1); PG8_BAR;
            PG8_LDA(At, 0, 1); PG8_STAGE(PG8_SA(0, 0), a2, voffA);
            PG8_BAR; PG8_WAIT_L(0); PG8_MMA(1, 0, At, B0); PG8_BAR; PG8_SCHED;
            PG8_STAGE(PG8_SB(0, 1), b2 + hstep, voffB);
            PG8_WAIT_V(6); PG8_BAR; PG8_MMA(1, 1, At, B1); PG8_BAR;
            PG8_LDB(B0, 1, 0); PG8_SCHED; PG8_LDA(At, 1, 0); PG8_STAGE(PG8_SA(0, 1), a2 + hstep, voffA);
            PG8_WAIT_L(8); PG8_BAR; PG8_WAIT_L(0); PG8_MMA(0, 0, At, B0); PG8_BAR; PG8_SCHED;
            PG8_LDB(B1, 1, 1); PG8_STAGE(PG8_SB(1, 0), b3, voffB);
            PG8_BAR; PG8_WAIT_L(0); PG8_MMA(0, 1, At, B1); PG8_BAR;
            PG8_LDA(At, 1, 1); PG8_STAGE(PG8_SA(1, 0), a3, voffA);
            PG8_BAR; PG8_WAIT_L(0); PG8_MMA(1, 0, At, B0); PG8_BAR; PG8_SCHED;
            PG8_STAGE(PG8_SB(1, 1), b3 + hstep, voffB);
            PG8_WAIT_V(6); PG8_BAR; PG8_MMA(1, 1, At, B1); PG8_BAR;
            }
        }
        if constexpr (ALIGN_EPI) { if (wr == 0) PG8_BAR; }
        if constexpr (FP8) asm volatile("s_nop 15\n\ts_nop 15" ::: "memory");
        if constexpr (!Epi::AFTER_DRAIN) { E(acc, cur, wr, wc, fr, fq); S.done(cur); }
        if (!has_next) break;
#pragma unroll
        for (int a = 0; a < 2; ++a)
#pragma unroll
            for (int b = 0; b < 2; ++b)
#pragma unroll
                for (int m = 0; m < 4; ++m)
#pragma unroll
                    for (int n = 0; n < 2; ++n) acc[a][b][m][n] = (f32x4){0.f, 0.f, 0.f, 0.f};
        cur = nxt; cA = nA; cB = nB; ++ui;
        if constexpr (ALIGN_EPI) { if (wr == 1) PG8_BAR; }
    }
    PG8_WAIT_V(0);
    if constexpr (!ALIGN_EPI) { if (wr == 0) PG8_BAR; }
    PG8_BAR;
    if constexpr (Epi::AFTER_DRAIN) { E.fused(acc, cur, wr, wc, fr, fq, lds, wid, lane); S.done(cur); }
#undef PG8_SA
#undef PG8_SB
#undef PG8_STAGE
#undef PG8_LDA
#undef PG8_LDB
#undef PG8_MMA
#undef PG8_CAT8
#undef PG8_WAIT_V
#undef PG8_WAIT_L
#undef PG8_BAR
#undef PG8_SCHED
}
}

constexpr int NWAVES = 8, NTHR = 512;
constexpr int NB = 8, SEQ = 4096, TT = NB * SEQ, DM = 1024, FF = 2816, NPROJ = 5632;
constexpr float QSCALE = 0.125f * 1.4426950408889634f;
constexpr float NEGBIG = -1e30f;

constexpr size_t MiB = 1u << 20;
constexpr size_t WS_CTL = 0, CTL_ZERO_BYTES = 1 * MiB;
constexpr size_t WS_MOD = 1 * MiB;
constexpr size_t WS_COS = 1 * MiB + 512 * 1024, WS_SIN = 2 * MiB;
constexpr size_t WS_SMALL = 2 * MiB + 512 * 1024;
constexpr size_t WS_CW1K = 3 * MiB, WS_CW1V = 3 * MiB + 512 * 1024;
constexpr size_t WS_KC = 4 * MiB, WS_VCT = 4 * MiB + 512 * 1024;
constexpr size_t WS_WNU = 5 * MiB, WS_WRU = 6 * MiB, WS_WO = 7 * MiB;
constexpr size_t WS_W1A = 9 * MiB, WS_W1B = 20 * MiB, WS_WIN = 26 * MiB, WS_W2A = 37 * MiB, WS_W2B = 48 * MiB;
constexpr size_t WS_U = 56 * MiB;
constexpr size_t WS_ONSA = 56 * MiB, WS_ORET = 88 * MiB;
constexpr size_t WS_HACT = 120 * MiB;
constexpr size_t WS_QN = 120 * MiB, WS_KVC = 152 * MiB, WS_KVS = 168 * MiB, WS_KVW = 184 * MiB, WS_RQ = 200 * MiB, WS_RK = 232 * MiB, WS_RV = 264 * MiB, WS_RG = 296 * MiB;
constexpr size_t WS_GA = 328 * MiB, WS_GB = 392 * MiB, WS_NG = 456 * MiB, WS_SLOC = 458 * MiB, WS_STOT = 490 * MiB, WS_END = 494 * MiB;
constexpr size_t WS_H3 = 328 * MiB;
constexpr size_t WS_MIXED = 200 * MiB;
constexpr int CW_BAR = 4096;
constexpr size_t WS_SS2 = WS_CTL + 256 * 1024, WS_SS3 = WS_CTL + 512 * 1024;
constexpr size_t WS_CV2 = WS_MOD + 294912, WS_CV3 = WS_SMALL + 131072;

constexpr int RING_BYTES = 131072, LDSCTL_OFF = RING_BYTES, MISC_OFF = LDSCTL_OFF + 320, LDS_BYTES = 147456;

#define GAS __attribute__((address_space(1)))
#define LAS __attribute__((address_space(3)))
typedef unsigned short bf16;
typedef unsigned v4u __attribute__((ext_vector_type(4)));
typedef unsigned v2u __attribute__((ext_vector_type(2)));
typedef float f32x4 __attribute__((ext_vector_type(4)));
typedef float f32x16 __attribute__((ext_vector_type(16)));
typedef short bf16x8 __attribute__((ext_vector_type(8)));
typedef short s16x4 __attribute__((ext_vector_type(4)));
typedef GAS unsigned gu32;
#define RLX_AGENT __ATOMIC_RELAXED, __HIP_MEMORY_SCOPE_AGENT
#define LDS_WAIT() asm volatile("s_waitcnt lgkmcnt(0)" ::: "memory")
using pg8::bflo; using pg8::bfhi; using pg8::fsilu; using pg8::fsigm;
#define XB_TMO      128
#define XB_XCNT(j)  (256  + 64 * (j))
#define XB_XSUB(j)  (1280 + 64 * (j))
#define XB_XGEN(j)  (2304 + 64 * (j))
#define XB_TOP      3328
#define XB_TOPGEN   3392
#define XCD_BAR_WORDS 3456
#define XB_SPIN_CAP (1u << 18)

__device__ __forceinline__ unsigned xb_ld(unsigned* p)              { return __hip_atomic_load(p, __ATOMIC_RELAXED, __HIP_MEMORY_SCOPE_AGENT); }
__device__ __forceinline__ unsigned xb_add(unsigned* p, unsigned v) { return __hip_atomic_fetch_add(p, v, __ATOMIC_RELAXED, __HIP_MEMORY_SCOPE_AGENT); }
__device__ __forceinline__ unsigned xb_xcc_id() { return (unsigned)__builtin_amdgcn_s_getreg((3 << 11) | 20) & 0xFu; }
#define XB_SPIN(cond, bar) do { unsigned _sp = 0; while (cond) { __builtin_amdgcn_s_sleep(1); \
    if ((++_sp & 255u) == 0u) { if (xb_ld(&(bar)[XB_TMO])) break; if (_sp > XB_SPIN_CAP) { atomicAdd(&(bar)[XB_TMO], 1u); break; } } } } while (0)

struct XcdBarrier {
    unsigned* bar; unsigned x;
    volatile LAS unsigned* st;
};

__device__ __forceinline__ XcdBarrier xcd_barrier_post(unsigned* bar, volatile LAS unsigned* st) {
    XcdBarrier b; b.bar = bar; b.x = xb_xcc_id(); b.st = st;
    if (threadIdx.x == 0) (void)xb_add(&bar[XB_XCNT(b.x)], 1u);
    return b;
}
__device__ __forceinline__ void xcd_barrier_complete(unsigned* bar, unsigned x, unsigned& nloc, unsigned& nx) {
    const unsigned G = gridDim.x * gridDim.y * gridDim.z;
    unsigned sum, cnt, mine, sp = 0u;
    for (;;) {
        sum = 0u; cnt = 0u; mine = 0u;
#pragma unroll
        for (unsigned j = 0; j < 16; ++j) { const unsigned c = xb_ld(&bar[XB_XCNT(j)]); sum += c; cnt += (c > 0u) ? 1u : 0u; mine = (j == x) ? c : mine; }
        if (sum == G) break;
        __builtin_amdgcn_s_sleep(1);
        if ((++sp & 255u) == 0u) { if (xb_ld(&bar[XB_TMO])) break; if (sp > XB_SPIN_CAP) { atomicAdd(&bar[XB_TMO], 1u); break; } }
    }
    nloc = mine > 0u ? mine : 1u; nx = cnt > 0u ? cnt : 1u;
}

__device__ __forceinline__ void xcd_barrier(const XcdBarrier& b) {
    asm volatile("s_waitcnt vmcnt(0)" ::: "memory");
    __syncthreads();
    if (threadIdx.x == 0) {
        unsigned* bar = b.bar;
        __builtin_amdgcn_s_waitcnt(0);
        unsigned nloc = b.st[0], nx = b.st[1];
        if (nloc == 0u) { xcd_barrier_complete(bar, b.x, nloc, nx); b.st[0] = nloc; b.st[1] = nx; }
        const unsigned old = xb_add(&bar[XB_XSUB(b.x)], 1u);
        const unsigned gen = old / nloc;
        if (old + 1u == (gen + 1u) * nloc) {
            __builtin_amdgcn_fence(__ATOMIC_RELEASE, "agent");
            asm volatile("s_waitcnt vmcnt(0)" ::: "memory");
            const unsigned og = xb_add(&bar[XB_TOP], 1u);
            const unsigned tg = og / nx;
            if (og + 1u == (tg + 1u) * nx) xb_add(&bar[XB_TOPGEN], 1u);
            else XB_SPIN(xb_ld(&bar[XB_TOPGEN]) == tg, bar);
            __builtin_amdgcn_fence(__ATOMIC_ACQUIRE, "agent");
            xb_add(&bar[XB_XGEN(b.x)], 1u);
            asm volatile("s_waitcnt vmcnt(0)" ::: "memory");
        } else {
            XB_SPIN(xb_ld(&bar[XB_XGEN(b.x)]) == gen, bar);
            __builtin_amdgcn_fence(__ATOMIC_ACQUIRE, "agent");
            asm volatile("s_waitcnt vmcnt(0)" ::: "memory");
        }
    }
    __syncthreads();
}

__device__ __forceinline__ float wave_sum(float v) {
#pragma unroll
    for (int o = 1; o < 64; o <<= 1) v += __shfl_xor(v, o);
    return v;
}
__device__ __forceinline__ bf16x8 ld16g(const bf16* p) { return __builtin_bit_cast(bf16x8, *(const GAS v4u*)p); }
__device__ __forceinline__ bf16x8 ld16l(const LAS unsigned char* p) { return *(const LAS bf16x8*)p; }
typedef short v4i16_t __attribute__((ext_vector_type(4)));
__device__ __forceinline__ s16x4 vtr(const LAS unsigned char* p) { return __builtin_bit_cast(s16x4, __builtin_amdgcn_ds_read_tr16_b64_v4i16((LAS v4i16_t*)p)); }
__device__ __forceinline__ bf16x8 cat8(s16x4 a, s16x4 b) { return (bf16x8){a[0], a[1], a[2], a[3], b[0], b[1], b[2], b[3]}; }
__device__ __forceinline__ float quad_xor1(float x) { return __builtin_bit_cast(float, __builtin_amdgcn_update_dpp(0, __builtin_bit_cast(int, x), 0xB1, 0xF, 0xF, true)); }
__device__ __forceinline__ float quad_xor2(float x) { return __builtin_bit_cast(float, __builtin_amdgcn_update_dpp(0, __builtin_bit_cast(int, x), 0x4E, 0xF, 0xF, true)); }
__device__ __forceinline__ float xmax(float x) { return fmaxf(x, __shfl_xor(x, 32)); }
__device__ __forceinline__ float xsum(float x) { return x + __shfl_xor(x, 32); }
__device__ __forceinline__ float xpartner(float x, int h) { (void)h; return __shfl_xor(x, 32); }
__device__ __forceinline__ int crow(int r, int hi) { return (r & 3) + 8 * (r >> 2) + 4 * hi; }
__device__ __forceinline__ f32x4 mfma16(bf16x8 a, bf16x8 b, f32x4 c) { return __builtin_amdgcn_mfma_f32_16x16x32_bf16(a, b, c, 0, 0, 0); }
__device__ __forceinline__ f32x16 mfma32(bf16x8 a, bf16x8 b, f32x16 c) { return __builtin_amdgcn_mfma_f32_32x32x16_bf16(a, b, c, 0, 0, 0); }
typedef float f32x2_t __attribute__((ext_vector_type(2))); typedef __bf16 bf16x2_t __attribute__((ext_vector_type(2)));
__device__ __forceinline__ unsigned cvtpk(float lo, float hi) { f32x2_t v = {lo, hi}; bf16x2_t b = __builtin_convertvector(v, bf16x2_t); return __builtin_bit_cast(unsigned, b); }
__device__ __forceinline__ float fexp2(float x) { return __builtin_amdgcn_exp2f(x); }
__device__ __forceinline__ float log2g(int h) {
    return h == 0 ? -0.04580368961312479f : h == 1 ? -0.02272007650008353f : h == 2 ? -0.011315313227834146f : h == 3 ? -0.005646563141142063f
         : h == 4 ? -0.0028205190623786626f : h == 5 ? -0.0014095702546713536f : h == 6 ? -0.0007046129765893727f : -0.0003522634716290214f;
}

struct Args {
    const float *x, *c, *ada_w, *ada_b, *norm1_w, *ffn1_w_in, *ffn1_w_out, *norm2_w, *w_in, *cmp_k_pe, *cmp_k_w1, *cmp_k_w2, *cmp_v_pe, *cmp_v_w1, *cmp_v_w2,
                *ret_norm_w, *w_nsa_up, *w_ret_up, *w_out, *norm3_w, *ffn2_w_in, *ffn2_w_out, *final_norm_w;
    float* out; unsigned char* ws; int ph_lo, ph_hi;
};

template <int MAT> __device__ __forceinline__ int srccol(int r) {
    if (MAT == 1) { const int p = r >> 8, q = r & 255; return q < 128 ? 128 * p + q : FF + 128 * p + (q - 128); }
    if (MAT == 2) {
        if (r < 1280) return r;
        if (r < 2304) { const int base = r < 1792 ? 1304 : 1816; const int l = (r - 1280) & 511; const int hd = l >> 6, p = l & 63; return base + hd * 64 + ((p & 1) ? (p >> 1) + 32 : (p >> 1)); }
        if (r < 5376) return r + 24;
        if (r < 5400) return r - 5376 + 1280;
        return -1;
    }
    return r;
}
__device__ __forceinline__ unsigned f2bf(float f) { unsigned u = __builtin_bit_cast(unsigned, f); return (u + 0x7fffu + ((u >> 16) & 1u)) >> 16; }
__device__ __forceinline__ unsigned pk2(float lo, float hi) { return f2bf(lo) | (f2bf(hi) << 16); }
template <int MAT> __device__ __forceinline__ void transpose_item(const float* W, int K, int N, bf16* WT, LAS float* scr, int item, int nblk, int lane) {
    const int kb = item / nblk, nb = item % nblk, k0 = 64 * kb, r0 = 32 * nb;
    const int col = srccol<MAT>(r0 + (lane & 31));
    float tv[32];
#pragma unroll
    for (int i = 0; i < 32; ++i) { const int kk = 2 * i + (lane >> 5); tv[i] = col >= 0 ? W[(size_t)(k0 + kk) * N + col] : 0.f; }
#pragma unroll
    for (int i = 0; i < 32; ++i) { const int kk = 2 * i + (lane >> 5); scr[kk * 33 + (lane & 31)] = tv[i]; }
    LDS_WAIT(); asm volatile("" ::: "memory");
    const int c = lane & 7;
#pragma unroll
    for (int j = 0; j < 4; ++j) { const int n = (lane >> 3) + 8 * j; const LAS float* s = scr + (8 * c) * 33 + n;
        v4u o; o.x = pk2(s[0 * 33], s[1 * 33]); o.y = pk2(s[2 * 33], s[3 * 33]); o.z = pk2(s[4 * 33], s[5 * 33]); o.w = pk2(s[6 * 33], s[7 * 33]);
        *(GAS v4u*)(WT + (size_t)(r0 + n) * K + k0 + 8 * c) = o; }
    LDS_WAIT(); asm volatile("" ::: "memory");
}
__device__ __forceinline__ void transpose_item_fp8(const float* W, int K, int N, unsigned char* WT, LAS float* scr, int item, int nblk, int lane) {
    const int kb = item / nblk, nb = item % nblk, k0 = 64 * kb, r0 = 32 * nb;
    const int col = r0 + (lane & 31);
    float tv[32];
#pragma unroll
    for (int i = 0; i < 32; ++i) { const int kk = 2 * i + (lane >> 5); tv[i] = W[(size_t)(k0 + kk) * N + col]; }
#pragma unroll
    for (int i = 0; i < 32; ++i) { const int kk = 2 * i + (lane >> 5); scr[kk * 33 + (lane & 31)] = tv[i] * 64.f; }
    LDS_WAIT(); asm volatile("" ::: "memory");
    const int c = lane & 7;
#pragma unroll
    for (int j = 0; j < 4; ++j) { const int n = (lane >> 3) + 8 * j; const LAS float* s = scr + (8 * c) * 33 + n;
        const f32x4 lo = {s[0 * 33], s[1 * 33], s[2 * 33], s[3 * 33]}, hi = {s[4 * 33], s[5 * 33], s[6 * 33], s[7 * 33]};
        *(GAS v2u*)(WT + (size_t)(r0 + n) * K + k0 + 8 * c) = pg8::pk8_fp8(lo, hi); }
    LDS_WAIT(); asm volatile("" ::: "memory");
}
__device__ const double ROPE_INVF[32] = {1.0, 0.7498942093324559, 0.5623413251903491, 0.4216965034285822, 0.31622776601683794, 0.23713737056616552, 0.1778279410038923, 0.1333521432163324, 0.1, 0.07498942093324558, 0.05623413251903491, 0.042169650342858224, 0.03162277660168379, 0.023713737056616554, 0.01778279410038923, 0.01333521432163324, 0.01, 0.007498942093324558, 0.005623413251903491, 0.004216965034285823, 0.0031622776601683794, 0.0023713737056616554, 0.0017782794100389228, 0.001333521432163324, 0.001, 0.0007498942093324559, 0.0005623413251903491, 0.00042169650342858224, 0.00031622776601683794, 0.00023713737056616554, 0.00017782794100389227, 0.0001333521432163324};

__device__ __forceinline__ void p0_prologue(const Args& a, LAS unsigned char* lds, int tid, int lane, int wave, int vcu, int G) {
    unsigned char* ws = a.ws;
    for (int item = blockIdx.x; item < 144; item += G) {
        LAS float* scs = (LAS float*)lds;
        LAS float* red = (LAS float*)(lds + 32768);
        for (int e = tid; e < 8192; e += NTHR) scs[e] = fsilu(a.c[e]);
        __syncthreads();
        const int n0 = 64 * item, cl = tid & 63, kg = tid >> 6;
        float acc[8];
#pragma unroll
        for (int b = 0; b < 8; ++b) acc[b] = 0.f;
#pragma unroll 16
        for (int k = kg * 128; k < kg * 128 + 128; ++k) { const float w = a.ada_w[(size_t)k * 9216 + n0 + cl];
#pragma unroll
            for (int b = 0; b < 8; ++b) acc[b] += scs[b * 1024 + k] * w; }
#pragma unroll
        for (int b = 0; b < 8; ++b) red[(kg * 8 + b) * 64 + cl] = acc[b];
        __syncthreads();
        { const int b = tid >> 6; float s = a.ada_b[n0 + cl];
#pragma unroll
          for (int g = 0; g < 8; ++g) s += red[(g * 8 + b) * 64 + cl];
          ((float*)(ws + WS_MOD))[b * 9216 + n0 + cl] = s; }
        __syncthreads();
    }
    for (int item = blockIdx.x - 144; item < 2; item += G) {
        if (item < 0) continue;
        const float* pe = item == 0 ? a.cmp_k_pe : a.cmp_v_pe; const float* w1 = item == 0 ? a.cmp_k_w1 : a.cmp_v_w1;
        LAS float* red = (LAS float*)lds;
        const int j = tid & 127, kg = tid >> 7; float s = 0.f;
#pragma unroll 4
        for (int k = kg * 512; k < kg * 512 + 512; ++k) s += pe[k] * w1[(size_t)k * 128 + j];
        red[kg * 128 + j] = s;
        __syncthreads();
        if (tid < 128) ((float*)(ws + WS_SMALL + 1024 * item))[tid] = red[tid] + red[128 + tid] + red[256 + tid] + red[384 + tid];
        __syncthreads();
    }
    for (int e = blockIdx.x * NTHR + tid; e < SEQ * 32; e += G * NTHR) {
        const int t = e >> 5, i = e & 31;
        const double ang = (double)t * ROPE_INVF[i];
        const double n = __builtin_rint(ang * 0.6366197723675814);
        double y = __builtin_fma(-n, 1.5707963267948966, ang); y = __builtin_fma(-n, 6.123233995736766e-17, y);
        const double y2 = y * y;
        double sn = -1.0 / 6227020800.0; sn = sn * y2 + 1.0 / 39916800.0; sn = sn * y2 - 1.0 / 362880.0; sn = sn * y2 + 1.0 / 5040.0; sn = sn * y2 - 1.0 / 120.0; sn = sn * y2 + 1.0 / 6.0; sn = y - y * y2 * sn;
        double cs = 1.0 / 87178291200.0; cs = cs * y2 - 1.0 / 479001600.0; cs = cs * y2 + 1.0 / 3628800.0; cs = cs * y2 - 1.0 / 40320.0; cs = cs * y2 + 1.0 / 720.0; cs = cs * y2 - 1.0 / 24.0; cs = cs * y2 + 0.5; cs = 1.0 - y2 * cs;
        const int q = ((int)n) & 3;
        const double sv = q == 0 ? sn : q == 1 ? cs : q == 2 ? -sn : -cs;
        const double cv = q == 0 ? cs : q == 1 ? -sn : q == 2 ? -cs : sn;
        ((float*)(ws + WS_COS))[e] = (float)cv; ((float*)(ws + WS_SIN))[e] = (float)sv;
    }
    __syncthreads();
    LAS float* scr = (LAS float*)(lds + wave * 16384);
    const int gw = vcu * NWAVES + wave, NGW = G * NWAVES;
    constexpr int I1 = 16 * 176, I2 = 44 * 32, I3 = 16 * 176, I4 = 8 * 32, I5 = 8 * 32, I6 = 16 * 32, I7 = I1, I8 = I2, I9 = 32 * 4, I10 = 32 * 4, I11 = 2 * 2, I12 = 2 * 2;
    constexpr int NITEMS = I1 + I2 + I3 + I4 + I5 + I6 + I7 + I8 + I9 + I10 + I11 + I12;
    for (int it = gw; it < NITEMS; it += NGW) {
        int r = it;
        if (r < I1) { transpose_item<1>(a.ffn1_w_in, 1024, 2 * FF, (bf16*)(ws + WS_W1A), scr, r, 176, lane); continue; } r -= I1;
        if (r < I2) { transpose_item<0>(a.ffn1_w_out, FF, 1024, (bf16*)(ws + WS_W1B), scr, r, 32, lane); continue; } r -= I2;
        if (r < I3) { transpose_item<2>(a.w_in, 1024, 5400, (bf16*)(ws + WS_WIN), scr, r, 176, lane); continue; } r -= I3;
        if (r < I4) { transpose_item<0>(a.w_nsa_up, 512, 1024, (bf16*)(ws + WS_WNU), scr, r, 32, lane); continue; } r -= I4;
        if (r < I5) { transpose_item<0>(a.w_ret_up, 512, 1024, (bf16*)(ws + WS_WRU), scr, r, 32, lane); continue; } r -= I5;
        if (r < I6) { transpose_item<0>(a.w_out, 1024, 1024, (bf16*)(ws + WS_WO), scr, r, 32, lane); continue; } r -= I6;
        if (r < I7) { transpose_item<1>(a.ffn2_w_in, 1024, 2 * FF, (bf16*)(ws + WS_W2A), scr, r, 176, lane); continue; } r -= I7;
        if (r < I8) { transpose_item_fp8(a.ffn2_w_out, FF, 1024, (unsigned char*)(ws + WS_W2B), scr, r, 32, lane); continue; } r -= I8;
        if (r < I9) { transpose_item<0>(a.cmp_k_w1, 2048, 128, (bf16*)(ws + WS_CW1K), scr, r, 4, lane); continue; } r -= I9;
        if (r < I10) { transpose_item<0>(a.cmp_v_w1, 2048, 128, (bf16*)(ws + WS_CW1V), scr, r, 4, lane); continue; } r -= I10;
        if (r < I11) { transpose_item<0>(a.cmp_k_w2, 128, 64, (bf16*)(ws + WS_SMALL + 4096), scr, r, 2, lane); continue; } r -= I11;
        transpose_item<0>(a.cmp_v_w2, 128, 64, (bf16*)(ws + WS_SMALL + 4096 + 16384), scr, r, 2, lane);
    }
}

template <bool XF32> __device__ __forceinline__ void load_row16(const void* X, size_t row, int lane, f32x4 (&v)[4]) {
    if (XF32) { const GAS f32x4* xr = (const GAS f32x4*)((const float*)X + row * DM);
        v[0] = xr[2 * lane]; v[1] = xr[2 * lane + 1]; v[2] = xr[128 + 2 * lane]; v[3] = xr[128 + 2 * lane + 1]; }
    else { const GAS v4u* xr = (const GAS v4u*)((const bf16*)X + row * DM);
        const v4u a = xr[lane], b = xr[64 + lane];
        v[0] = (f32x4){bflo(a.x), bfhi(a.x), bflo(a.y), bfhi(a.y)}; v[1] = (f32x4){bflo(a.z), bfhi(a.z), bflo(a.w), bfhi(a.w)};
        v[2] = (f32x4){bflo(b.x), bfhi(b.x), bflo(b.y), bfhi(b.y)}; v[3] = (f32x4){bflo(b.z), bfhi(b.z), bflo(b.w), bfhi(b.w)}; }
}
template <bool XF32> __device__ __forceinline__ void norm_mod_phase(const void* X, const float* w, const float* mod, int ch_sh, int ch_sc, bf16* U, int gw, int NGW, int lane) {
    for (int row0 = gw; row0 < TT; row0 += 4 * NGW) {
        f32x4 v[4][4];
#pragma unroll
        for (int i = 0; i < 4; ++i) { const int row = row0 + i * NGW; load_row16<XF32>(X, (size_t)(row < TT ? row : row0), lane, v[i]); }
#pragma unroll
        for (int i = 0; i < 4; ++i) { const int row = row0 + i * NGW; if (row >= TT) break;
            float ss = 0.f;
#pragma unroll
            for (int j = 0; j < 4; ++j) ss += (v[i][j].x * v[i][j].x + v[i][j].y * v[i][j].y) + (v[i][j].z * v[i][j].z + v[i][j].w * v[i][j].w);
            const float rstd = __builtin_amdgcn_rsqf(wave_sum(ss) * (1.f / DM) + 1e-6f);
            const float* mb = mod + (size_t)(row >> 12) * 9216;
            GAS v4u* o16 = (GAS v4u*)(U + (size_t)row * DM);
#pragma unroll
            for (int c = 0; c < 2; ++c) {
                f32x4 y[2];
#pragma unroll
                for (int q = 0; q < 2; ++q) { const int i4 = 128 * c + 2 * lane + q;
                    const f32x4 wv = ((const f32x4*)w)[i4], sh = ((const f32x4*)(mb + ch_sh * 1024))[i4], sc = ((const f32x4*)(mb + ch_sc * 1024))[i4];
                    y[q] = v[i][2 * c + q] * rstd * wv * (sc + 1.f) + sh; }
                v4u o; o.x = cvtpk(y[0].x, y[0].y); o.y = cvtpk(y[0].z, y[0].w); o.z = cvtpk(y[1].x, y[1].y); o.w = cvtpk(y[1].z, y[1].w);
                o16[64 * c + lane] = o;
            }
        }
    }
}
__device__ __forceinline__ void final_norm_phase(const bf16* H, float* O, const float* w, int gw, int NGW, int lane) {
    for (int row0 = gw; row0 < TT; row0 += 4 * NGW) {
        f32x4 v[4][4];
#pragma unroll
        for (int i = 0; i < 4; ++i) { const int row = row0 + i * NGW; load_row16<false>(H, (size_t)(row < TT ? row : row0), lane, v[i]); }
#pragma unroll
        for (int i = 0; i < 4; ++i) { const int row = row0 + i * NGW; if (row >= TT) break;
            float ss = 0.f;
#pragma unroll
            for (int j = 0; j < 4; ++j) ss += (v[i][j].x * v[i][j].x + v[i][j].y * v[i][j].y) + (v[i][j].z * v[i][j].z + v[i][j].w * v[i][j].w);
            const float rstd = __builtin_amdgcn_rsqf(wave_sum(ss) * (1.f / DM) + 1e-6f);
            GAS f32x4* orow = (GAS f32x4*)(O + (size_t)row * DM);
#pragma unroll
            for (int c = 0; c < 2; ++c)
#pragma unroll
                for (int q = 0; q < 2; ++q) { const int i4 = 128 * c + 2 * lane + q; orow[i4] = v[i][2 * c + q] * rstd * ((const f32x4*)w)[i4]; }
        }
    }
}

__device__ __forceinline__ void cvec_phase(const unsigned char* ws_c, const float* mod, LAS unsigned char* lds, int tid, int lane, int gw, int NGW) {
    unsigned char* ws = (unsigned char*)ws_c;
    LAS float* shl = (LAS float*)lds;
    f32x4 sv[8];
#pragma unroll
    for (int i = 0; i < 8; ++i) { const int e4 = tid + i * NTHR, r4 = e4 & 2047; sv[i] = *(const GAS f32x4*)(mod + (size_t)(r4 >> 8) * 9216 + ((e4 >> 11) ? 6 : 3) * 1024 + 4 * (r4 & 255)); }
    v4u wa[2][3], wb[2][3];
#pragma unroll
    for (int w = 0; w < 2; ++w)
#pragma unroll
        for (int i = 0; i < 3; ++i) { const int n = gw + i * NGW; const GAS v4u* wrow = (const GAS v4u*)((const bf16*)(ws + (w ? WS_W2A : WS_WIN)) + (size_t)(n < NPROJ ? n : gw) * DM);
            wa[w][i] = wrow[lane]; wb[w][i] = wrow[64 + lane]; }
#pragma unroll
    for (int i = 0; i < 8; ++i) ((LAS f32x4*)shl)[tid + i * NTHR] = sv[i];
    __syncthreads();
    const bool b2 = (lane & 4) != 0, b1 = (lane & 2) != 0, b0 = (lane & 1) != 0;
#pragma unroll
    for (int w = 0; w < 2; ++w)
#pragma unroll
        for (int i = 0; i < 3; ++i) { const int n = gw + i * NGW; if (n >= NPROJ) continue;
            const v4u a = wa[w][i], b = wb[w][i];
            const f32x4 w0 = {bflo(a.x), bfhi(a.x), bflo(a.y), bfhi(a.y)}, w1 = {bflo(a.z), bfhi(a.z), bflo(a.w), bfhi(a.w)};
            const f32x4 w2 = {bflo(b.x), bfhi(b.x), bflo(b.y), bfhi(b.y)}, w3 = {bflo(b.z), bfhi(b.z), bflo(b.w), bfhi(b.w)};
            float p[8];
#pragma unroll
            for (int bb = 0; bb < 8; ++bb) { const LAS f32x4* sp = (const LAS f32x4*)(shl + w * 8192 + bb * 1024);
                const f32x4 t = w0 * sp[2 * lane] + w1 * sp[2 * lane + 1] + w2 * sp[128 + 2 * lane] + w3 * sp[128 + 2 * lane + 1];
                p[bb] = (t.x + t.y) + (t.z + t.w); }
            float q[4], r[2];
#pragma unroll
            for (int j = 0; j < 4; ++j) q[j] = (b2 ? p[j + 4] : p[j]) + __shfl_xor(b2 ? p[j] : p[j + 4], 4);
#pragma unroll
            for (int j = 0; j < 2; ++j) r[j] = (b1 ? q[j + 2] : q[j]) + quad_xor2(b1 ? q[j] : q[j + 2]);
            float t1 = (b0 ? r[1] : r[0]) + quad_xor1(b0 ? r[0] : r[1]);
            t1 += __shfl_xor(t1, 8); t1 += __shfl_xor(t1, 16); t1 += __shfl_xor(t1, 32);
            if (lane < 8) ((float*)(ws + (w ? WS_CV3 : WS_CV2)))[(size_t)lane * NPROJ + n] = t1; }
    __syncthreads();
}

__device__ __forceinline__ void compress_unit(int u, const unsigned char* ws_c, LAS unsigned char* lds, int lane, int wave) {
    asm volatile("" : "+v"(lane));
    unsigned char* ws = (unsigned char*)ws_c;
    const int kv = u & 1, g = (u >> 1) & 1, b = (u >> 2) & 7, rt = u >> 5, n0 = 32 * rt;
    const bf16* KVC = (const bf16*)(ws + WS_KVC);
    const bf16* W1t = (const bf16*)(ws + (kv ? WS_CW1V : WS_CW1K));
    const bf16* W2t = (const bf16*)(ws + WS_SMALL + 4096 + 16384 * kv);
    const float* bias1 = (const float*)(ws + WS_SMALL + 1024 * kv);
    const int fr = lane & 15, fq = lane >> 4, rh = wave >> 2, cg = wave & 3;
    const int nrow = n0 + 16 * rh + fr;
    const bf16* arow = KVC + (size_t)b * SEQ * 256 + kv * 128 + g * 64 + 8 * fq;
    f32x4 acc[8];
#pragma unroll
    for (int nt = 0; nt < 8; ++nt) acc[nt] = (f32x4){0.f, 0.f, 0.f, 0.f};
    const bf16* b0p = W1t + (size_t)fr * 2048 + 8 * fq;
#pragma unroll 4
    for (int kk = 0; kk < 16; ++kk) { const int ks = 16 * cg + kk;
        int tok = 16 * nrow + (ks >> 1); tok = tok > SEQ - 1 ? SEQ - 1 : tok;
        const bf16x8 af = ld16g(arow + (size_t)tok * 256 + 32 * (ks & 1));
#pragma unroll
        for (int nt = 0; nt < 8; ++nt) acc[nt] = mfma16(af, ld16g(b0p + (size_t)nt * 16 * 2048 + 32 * ks), acc[nt]);
    }
    LAS float* red = (LAS float*)(lds + 16384);
    LAS bf16* hb = (LAS bf16*)lds;
#pragma unroll
    for (int nt = 0; nt < 8; ++nt)
#pragma unroll
        for (int r = 0; r < 4; ++r) red[(cg * 32 + 16 * rh + 4 * fq + r) * 132 + 16 * nt + fr] = acc[nt][r];
    __syncthreads();
    { const int tid2 = wave * 64 + lane;
      const int row = tid2 >> 4, c0 = (tid2 & 15) * 8;
#pragma unroll
      for (int j = 0; j < 8; ++j) { const int col = c0 + j;
          const float v = (red[(0 * 32 + row) * 132 + col] + red[(1 * 32 + row) * 132 + col]) + (red[(2 * 32 + row) * 132 + col] + red[(3 * 32 + row) * 132 + col]) + bias1[col];
          hb[row * 136 + col] = (bf16)f2bf(fsilu(v)); } }
    __syncthreads();
    const int dt = cg;
    f32x4 acc2 = {0.f, 0.f, 0.f, 0.f};
#pragma unroll
    for (int ks = 0; ks < 4; ++ks) {
        const bf16x8 a2 = ld16l((const LAS unsigned char*)(hb + (16 * rh + fr) * 136 + 32 * ks + 8 * fq));
        const bf16x8 b2 = ld16g(W2t + (size_t)(16 * dt + fr) * 128 + 32 * ks + 8 * fq);
        acc2 = mfma16(a2, b2, acc2);
    }
    const int d = 16 * dt + fr, nb = n0 + 16 * rh + 4 * fq, bg = b * 2 + g;
    if (kv == 0) { bf16* KC = (bf16*)(ws + WS_KC);
#pragma unroll
        for (int r = 0; r < 4; ++r) KC[((size_t)bg * 256 + nb + r) * 64 + d] = (bf16)f2bf(acc2[r]);
    } else { bf16* VCT = (bf16*)(ws + WS_VCT);
        const int pos = (nb & ~12) | ((nb & 4) << 1) | ((nb & 8) >> 1);
        v2u o; o.x = cvtpk(acc2[0], acc2[1]); o.y = cvtpk(acc2[2], acc2[3]);
        *(GAS v2u*)(VCT + ((size_t)bg * 64 + d) * 256 + pos) = o; }
    __syncthreads();
}

constexpr int RS = 144;
template <bool SCALE> __device__ __forceinline__ void stage_chunk(const bf16* src, LAS unsigned char* dst, int tid, float lg) {
#pragma unroll
    for (int i = 0; i < 2; ++i) { const int idx = tid + NTHR * i, row = idx >> 3, ch = idx & 7;
        v4u q = *(const GAS v4u*)(src + (size_t)row * 512 + 8 * ch);
        if (SCALE) { const float f = fexp2(lg * (float)(127 - row));
            q.x = cvtpk(bflo(q.x) * f, bfhi(q.x) * f); q.y = cvtpk(bflo(q.y) * f, bfhi(q.y) * f); q.z = cvtpk(bflo(q.z) * f, bfhi(q.z) * f); q.w = cvtpk(bflo(q.w) * f, bfhi(q.w) * f); }
        *(LAS v4u*)(dst + row * RS + ch * 16) = q; }
}
struct ChunkRegs { v4u k[2], v[2]; };
__device__ __forceinline__ ChunkRegs load_chunk(int u, const unsigned char* ws, int tid) {
    const int n = u & 31, h = (u >> 5) & 7, b = u >> 8;
    const size_t off = ((size_t)b * SEQ + 128 * n) * 512 + h * 64;
    ChunkRegs c;
#pragma unroll
    for (int i = 0; i < 2; ++i) { const int idx = tid + NTHR * i, row = idx >> 3, ch = idx & 7;
        c.k[i] = *(const GAS v4u*)((const bf16*)(ws + WS_RK) + off + (size_t)row * 512 + 8 * ch);
        c.v[i] = *(const GAS v4u*)((const bf16*)(ws + WS_RV) + off + (size_t)row * 512 + 8 * ch); }
    return c;
}
template <bool SCALE> __device__ __forceinline__ void store_chunk(const ChunkRegs& c, LAS unsigned char* Ks, LAS unsigned char* Vs, int tid, float lg) {
#pragma unroll
    for (int i = 0; i < 2; ++i) { const int idx = tid + NTHR * i, row = idx >> 3, ch = idx & 7;
        v4u q = c.k[i];
        if (SCALE) { const float f = fexp2(lg * (float)(127 - row));
            q.x = cvtpk(bflo(q.x) * f, bfhi(q.x) * f); q.y = cvtpk(bflo(q.y) * f, bfhi(q.y) * f); q.z = cvtpk(bflo(q.z) * f, bfhi(q.z) * f); q.w = cvtpk(bflo(q.w) * f, bfhi(q.w) * f); }
        *(LAS v4u*)(Ks + row * RS + ch * 16) = q; *(LAS v4u*)(Vs + row * RS + ch * 16) = c.v[i]; }
}
__device__ __forceinline__ void sloc_unit(int u, const ChunkRegs& cr, unsigned char* ws, LAS unsigned char* lds, int tid, int lane, int wave, f32x4 (&run)[2], bool last) {
    asm volatile("" : "+v"(tid), "+v"(lane));
    const int n = u & 31, h = (u >> 5) & 7, b = u >> 8; const float lg = log2g(h);
    const size_t tok0 = (size_t)b * SEQ + 128 * n;
    LAS unsigned char* Ks = lds; LAS unsigned char* Vs = lds + 128 * RS;
    store_chunk<true>(cr, Ks, Vs, tid, lg);
    __syncthreads();
    const int fr = lane & 15, fq = lane >> 4, mt = wave >> 1, ntb = 2 * (wave & 1);
    f32x4 acc[2] = {{0.f, 0.f, 0.f, 0.f}, {0.f, 0.f, 0.f, 0.f}};
    const int roff = (8 * fq + (fr >> 2)) * RS + 8 * (lane & 3);
#pragma unroll
    for (int s = 0; s < 4; ++s) {
        const bf16x8 af = cat8(vtr(Vs + 32 * s * RS + roff + 32 * mt), vtr(Vs + (32 * s + 4) * RS + roff + 32 * mt));
#pragma unroll
        for (int t2 = 0; t2 < 2; ++t2) { const int nt = ntb + t2;
            const bf16x8 bf_ = cat8(vtr(Ks + 32 * s * RS + roff + 32 * nt), vtr(Ks + (32 * s + 4) * RS + roff + 32 * nt));
            acc[t2] = mfma16(af, bf_, acc[t2]); }
    }
    const float cd = fexp2(lg * 128.f);
    float* SL = (float*)(ws + WS_SLOC) + (size_t)u * 4096;
#pragma unroll
    for (int t2 = 0; t2 < 2; ++t2) {
#pragma unroll
        for (int r = 0; r < 4; ++r) SL[(16 * mt + 4 * fq + r) * 64 + 16 * (ntb + t2) + fr] = run[t2][r];
        run[t2] = run[t2] * cd + acc[t2]; }
    if (last) { float* ST = (float*)(ws + WS_STOT) + (size_t)(u >> 3) * 4096;
#pragma unroll
        for (int t2 = 0; t2 < 2; ++t2)
#pragma unroll
            for (int r = 0; r < 4; ++r) ST[(16 * mt + 4 * fq + r) * 64 + 16 * (ntb + t2) + fr] = run[t2][r]; }
    __syncthreads();
}
__device__ __forceinline__ void ret_unit(int u, const ChunkRegs& cr, unsigned char* ws, const float* ret_norm_w, LAS unsigned char* lds, int tid, int lane, int wave) {
    asm volatile("" : "+v"(tid), "+v"(lane));
    const int n = u & 31, h = (u >> 5) & 7, b = u >> 8; const float lg = log2g(h);
    const size_t tok0 = (size_t)b * SEQ + 128 * n;
    LAS unsigned char* Ks = lds; LAS unsigned char* Vs = lds + 128 * RS; LAS unsigned char* St = lds + 256 * RS;
    const int fr = lane & 15, fq = lane >> 4;
    const int i = 16 * wave + fr; const size_t tok = tok0 + i;
    bf16x8 qf[2]; v2u rgv[4];
#pragma unroll
    for (int ks = 0; ks < 2; ++ks) qf[ks] = ld16g((const bf16*)(ws + WS_RQ) + tok * 512 + h * 64 + 32 * ks + 8 * fq);
#pragma unroll
    for (int mt = 0; mt < 4; ++mt) rgv[mt] = *(const GAS v2u*)((const bf16*)(ws + WS_RG) + tok * 512 + h * 64 + 16 * mt + 4 * fq);
    {
        const float cd8 = fexp2(lg * 1024.f);
        const float* ST = (const float*)(ws + WS_STOT) + (size_t)((u - n) >> 3) * 4096 + tid * 8;
        f32x4 s0 = {0.f, 0.f, 0.f, 0.f}, s1 = {0.f, 0.f, 0.f, 0.f};
        for (int gq = 0; gq < (n >> 3); ++gq) { const f32x4 a0 = *(const GAS f32x4*)(ST + (size_t)gq * 4096), a1 = *(const GAS f32x4*)(ST + (size_t)gq * 4096 + 4); s0 = s0 * cd8 + a0; s1 = s1 * cd8 + a1; }
        { const float ci = fexp2(lg * 128.f * (float)(n & 7)); const float* SL = (const float*)(ws + WS_SLOC) + (size_t)u * 4096 + tid * 8;
          s0 = s0 * ci + *(const GAS f32x4*)SL; s1 = s1 * ci + *(const GAS f32x4*)(SL + 4); }
        v4u o; o.x = cvtpk(s0[0], s0[1]); o.y = cvtpk(s0[2], s0[3]); o.z = cvtpk(s1[0], s1[1]); o.w = cvtpk(s1[2], s1[3]);
        *(LAS v4u*)(St + (tid >> 3) * RS + (tid & 7) * 16) = o;
    }
    store_chunk<false>(cr, Ks, Vs, tid, lg);
    __syncthreads();
    f32x4 o[4];
    const float qd = fexp2(lg * (float)(i + 1));
#pragma unroll
    for (int mt = 0; mt < 4; ++mt) { o[mt] = (f32x4){0.f, 0.f, 0.f, 0.f};
#pragma unroll
        for (int ks = 0; ks < 2; ++ks) o[mt] = mfma16(ld16l(St + (16 * mt + fr) * RS + (32 * ks + 8 * fq) * 2), qf[ks], o[mt]);
        o[mt] = o[mt] * qd; }
    v2u P[8];
#pragma unroll
    for (int jt = 0; jt < 8; ++jt) {
        P[jt] = (v2u){0u, 0u};
        if (jt <= wave) {
            f32x4 sa = {0.f, 0.f, 0.f, 0.f};
#pragma unroll
            for (int ks = 0; ks < 2; ++ks) sa = mfma16(ld16l(Ks + (16 * jt + fr) * RS + (32 * ks + 8 * fq) * 2), qf[ks], sa);
            float p[4];
#pragma unroll
            for (int r = 0; r < 4; ++r) { const int dl = i - (16 * jt + 4 * fq + r); p[r] = dl >= 0 ? sa[r] * fexp2(lg * (float)dl) : 0.f; }
            P[jt].x = cvtpk(p[0], p[1]); P[jt].y = cvtpk(p[2], p[3]);
        }
    }
    const int voff = (4 * fq + (fr >> 2)) * RS + 8 * (lane & 3);
#pragma unroll
    for (int s = 0; s < 4; ++s) {
        if (2 * s <= wave) {
            const bf16x8 pb = __builtin_bit_cast(bf16x8, (v4u){P[2 * s].x, P[2 * s].y, P[2 * s + 1].x, P[2 * s + 1].y});
#pragma unroll
            for (int mt = 0; mt < 4; ++mt) {
                const bf16x8 vf = cat8(vtr(Vs + 32 * s * RS + voff + 32 * mt), vtr(Vs + (32 * s + 16) * RS + voff + 32 * mt));
                o[mt] = mfma16(vf, pb, o[mt]); }
        }
    }
    float sm = 0.f;
#pragma unroll
    for (int mt = 0; mt < 4; ++mt) sm += (o[mt][0] + o[mt][1]) + (o[mt][2] + o[mt][3]);
    sm += __shfl_xor(sm, 16); sm += __shfl_xor(sm, 32);
    const float mu = sm * (1.f / 64.f);
    float sq = 0.f;
#pragma unroll
    for (int mt = 0; mt < 4; ++mt) { o[mt] = o[mt] - mu; sq += (o[mt][0] * o[mt][0] + o[mt][1] * o[mt][1]) + (o[mt][2] * o[mt][2] + o[mt][3] * o[mt][3]); }
    sq += __shfl_xor(sq, 16); sq += __shfl_xor(sq, 32);
    const float rstd = __builtin_amdgcn_rsqf(sq * (1.f / 64.f) + 1e-6f);
#pragma unroll
    for (int mt = 0; mt < 4; ++mt) { const int dv = 16 * mt + 4 * fq;
        const f32x4 w4 = *(const f32x4*)(ret_norm_w + h * 64 + dv);
        const v2u rg = rgv[mt];
        const f32x4 y = o[mt] * rstd * w4;
        v2u ov; ov.x = cvtpk(y[0] * bflo(rg.x), y[1] * bfhi(rg.x)); ov.y = cvtpk(y[2] * bflo(rg.y), y[3] * bfhi(rg.y));
        *(GAS v2u*)((bf16*)(ws + WS_ORET) + tok * 512 + h * 64 + dv) = ov; }
    __syncthreads();
}

constexpr int KRS = 144, VRS = 192;
constexpr int ATT_KB = 64 * KRS, ATT_VB = 64 * VRS, ATT_BUF = ATT_KB + ATT_VB;
constexpr int KC_RS = 144, VCT_RS = 528;
constexpr int KC_OFF = 0, VCT_OFF = 256 * KC_RS, ATT_OFF = VCT_OFF + 64 * VCT_RS;
__device__ __forceinline__ bf16x8 packp(const f32x16& p, int s) {
    return __builtin_bit_cast(bf16x8, (v4u){cvtpk(p[8 * s], p[8 * s + 1]), cvtpk(p[8 * s + 2], p[8 * s + 3]), cvtpk(p[8 * s + 4], p[8 * s + 5]), cvtpk(p[8 * s + 6], p[8 * s + 7])});
}
template <int MODE, bool SHIFT> __device__ __forceinline__ void attend(unsigned (&outp)[2][8], const bf16x8 (&qf)[4], float negm, const bf16* Kg, const bf16* Vg, int qb, int tl, unsigned long long selmask, float gate,
                                                            LAS unsigned char* lds, int tid, int lane, int wave) {
    asm volatile("" : "+v"(tid), "+v"(lane));
    const int r32 = lane & 31, h = lane >> 5;
    const bool grpB = wave >= 4;
    float l = 0.f;
    f32x16 o[2], cinit;
#pragma unroll
    for (int r = 0; r < 16; ++r) { o[0][r] = 0.f; o[1][r] = 0.f; cinit[r] = SHIFT ? negm : 0.f; }
    const int j0 = MODE == 0 ? 0 : (qb > 8 ? qb - 8 : 0);
    const int voff = (4 * h + ((lane & 15) >> 2)) * VRS + (16 * ((lane >> 4) & 1) + 4 * (lane & 3)) * 2;
    const int koff = r32 * KRS + 16 * h;
    const int srow = tid >> 3, sch = tid & 7;
    const bf16* kgp = Kg + (size_t)srow * 256 + 8 * sch; const bf16* vgp = Vg + (size_t)srow * 256 + 8 * sch;
    LAS unsigned char* stgK = lds + ATT_OFF; LAS unsigned char* stgV = stgK + 2 * ATT_KB;
    LAS unsigned char* wK = stgK + srow * KRS + sch * 16; LAS unsigned char* wV = stgV + srow * VRS + sch * 16;
    v4u kA = *(const GAS v4u*)(kgp + (size_t)(64 * j0) * 256), vA = *(const GAS v4u*)(vgp + (size_t)(64 * j0) * 256), kB = kA, vB = vA;
    __syncthreads();
    *(LAS v4u*)wK = kA; *(LAS v4u*)wV = vA;
    if (j0 < qb) { kA = *(const GAS v4u*)(kgp + (size_t)(64 * (j0 + 1)) * 256); vA = *(const GAS v4u*)(vgp + (size_t)(64 * (j0 + 1)) * 256); }
    __syncthreads();
    v4u pkp[4] = {{0u, 0u, 0u, 0u}, {0u, 0u, 0u, 0u}, {0u, 0u, 0u, 0u}, {0u, 0u, 0u, 0u}}; bool actp = false;
    int kb = 0, vcur = 0, vprev = 0;
#define ATT_VF(VS, S2, MD) cat8(vtr((VS) + (16 * (S2)) * VRS + voff + 64 * (MD)), vtr((VS) + (16 * (S2) + 8) * VRS + voff + 64 * (MD)))
#define ATT_PV(VS, PK) do { \
        _Pragma("unroll") for (int s2 = 0; s2 < 4; ++s2) { \
            _Pragma("unroll") for (int md = 0; md < 2; ++md) o[md] = mfma32(ATT_VF(VS, s2, md), __builtin_bit_cast(bf16x8, PK[s2]), o[md]); } } while (0)
#define ATT_STEP(J, KP, VP, KQ, VQ) do { \
        LAS unsigned char* Ks = stgK + kb * ATT_KB; LAS unsigned char* Vc = stgV + vcur * ATT_VB; LAS unsigned char* Vp = stgV + vprev * ATT_VB; \
        if ((J) + 2 <= qb) { KQ = *(const GAS v4u*)(kgp + (size_t)(64 * ((J) + 2)) * 256); VQ = *(const GAS v4u*)(vgp + (size_t)(64 * ((J) + 2)) * 256); } \
        const bool rowok = MODE == 0 ? (((selmask >> (J)) & 1ull) != 0ull) : true; \
        const bool act = __any(rowok); \
        if (grpB && actp) ATT_PV(Vp, pkp); \
        v4u pk[4] = {{0u, 0u, 0u, 0u}, {0u, 0u, 0u, 0u}, {0u, 0u, 0u, 0u}, {0u, 0u, 0u, 0u}}; \
        if (act) { \
            bf16x8 kf[8]; \
            _Pragma("unroll") for (int i = 0; i < 8; ++i) kf[i] = ld16l(Ks + koff + (i >> 2) * 32 * KRS + (i & 3) * 32); \
            f32x16 s0 = cinit, s1 = cinit; \
            _Pragma("unroll") for (int ks = 0; ks < 4; ++ks) { s0 = mfma32(kf[ks], qf[ks], s0); s1 = mfma32(kf[4 + ks], qf[ks], s1); } \
            const bool lo_edge = (MODE == 1) && ((J) == qb - 8), hi_edge = ((J) == qb); \
            if (lo_edge || hi_edge) { \
                _Pragma("unroll") for (int r = 0; r < 16; ++r) { const int kl = crow(r, h); \
                    const bool ok0 = (!hi_edge || kl <= tl) && (!lo_edge || kl > tl), ok1 = (!hi_edge || kl + 32 <= tl) && (!lo_edge || kl + 32 > tl); \
                    s0[r] = ok0 ? s0[r] : NEGBIG; s1[r] = ok1 ? s1[r] : NEGBIG; } \
            } \
            float ls = 0.f; \
            _Pragma("unroll") for (int r = 0; r < 16; ++r) { s0[r] = fexp2(s0[r]); s1[r] = fexp2(s1[r]); ls += s0[r] + s1[r]; } \
            const unsigned rmask = rowok ? 0xffffffffu : 0u; \
            l += rowok ? ls : 0.f; \
            if (MODE == 1 || __all(rowok)) {                  \
            _Pragma("unroll") for (int s2 = 0; s2 < 4; ++s2) { const f32x16& p = (s2 >> 1) ? s1 : s0; const int e = 8 * (s2 & 1); \
                pk[s2] = (v4u){cvtpk(p[e], p[e + 1]), cvtpk(p[e + 2], p[e + 3]), cvtpk(p[e + 4], p[e + 5]), cvtpk(p[e + 6], p[e + 7])}; } \
            } else { \
            _Pragma("unroll") for (int s2 = 0; s2 < 4; ++s2) { const f32x16& p = (s2 >> 1) ? s1 : s0; const int e = 8 * (s2 & 1); \
                pk[s2] = (v4u){cvtpk(p[e], p[e + 1]) & rmask, cvtpk(p[e + 2], p[e + 3]) & rmask, cvtpk(p[e + 4], p[e + 5]) & rmask, cvtpk(p[e + 6], p[e + 7]) & rmask}; } } \
        } \
        if (!grpB) { if (act) ATT_PV(Vc, pk); } \
        else { _Pragma("unroll") for (int s2 = 0; s2 < 4; ++s2) pkp[s2] = pk[s2]; actp = act; } \
        const int vnext = vcur == 2 ? 0 : vcur + 1; \
        if ((J) < qb) { *(LAS v4u*)(wK + (1 - kb) * ATT_KB) = KP; *(LAS v4u*)(wV + vnext * ATT_VB) = VP; } \
        __syncthreads(); \
        kb ^= 1; vprev = vcur; vcur = vnext; \
    } while (0)
    int j = j0;
    for (; j + 1 <= qb; j += 2) { ATT_STEP(j, kA, vA, kB, vB); ATT_STEP(j + 1, kB, vB, kA, vA); }
    if (j <= qb) ATT_STEP(j, kA, vA, kB, vB);
    if (grpB && actp) { LAS unsigned char* Vp = stgV + vprev * ATT_VB; ATT_PV(Vp, pkp); }
#undef ATT_STEP
#undef ATT_PV
#undef ATT_VF
    l += __shfl_xor(l, 32);
    const float sc = gate / l;
#pragma unroll
    for (int md = 0; md < 2; ++md)
#pragma unroll
        for (int r = 0; r < 8; ++r) outp[md][r] = cvtpk(bflo(outp[md][r]) + o[md][2 * r] * sc, bfhi(outp[md][r]) + o[md][2 * r + 1] * sc);
}

constexpr int KCMAX_OFF = ATT_OFF + 2 * ATT_KB + 3 * ATT_VB;
__device__ __forceinline__ void load_cmp_images(int bg, const unsigned char* ws, LAS unsigned char* lds, int tid) {
    asm volatile("" : "+v"(tid));
    const bf16* KC = (const bf16*)(ws + WS_KC) + (size_t)bg * 256 * 64; const bf16* VCT = (const bf16*)(ws + WS_VCT) + (size_t)bg * 64 * 256;
    if (tid == 0) *(LAS unsigned*)(lds + KCMAX_OFF) = 0u;
    __syncthreads();
    float mx2 = 0.f;
#pragma unroll
    for (int i = 0; i < 4; ++i) { const int idx = tid + NTHR * i;
        const v4u kq = *(const GAS v4u*)(KC + (size_t)idx * 8);
        *(LAS v4u*)(lds + KC_OFF + (idx >> 3) * KC_RS + (idx & 7) * 16) = kq;
        *(LAS v4u*)(lds + VCT_OFF + (idx >> 5) * VCT_RS + (idx & 31) * 16) = *(const GAS v4u*)(VCT + (size_t)idx * 8);
        float p2 = (bflo(kq.x) * bflo(kq.x) + bfhi(kq.x) * bfhi(kq.x)) + (bflo(kq.y) * bflo(kq.y) + bfhi(kq.y) * bfhi(kq.y)) + (bflo(kq.z) * bflo(kq.z) + bfhi(kq.z) * bfhi(kq.z)) + (bflo(kq.w) * bflo(kq.w) + bfhi(kq.w) * bfhi(kq.w));
        p2 += __shfl_xor(p2, 1); p2 += __shfl_xor(p2, 2); p2 += __shfl_xor(p2, 4);
        mx2 = fmaxf(mx2, p2); }
#pragma unroll
    for (int o = 8; o < 64; o <<= 1) mx2 = fmaxf(mx2, __shfl_xor(mx2, o));
    if ((tid & 63) == 0) atomicMax((unsigned*)(lds + KCMAX_OFF), __builtin_bit_cast(unsigned, mx2));
}
constexpr size_t WS_KMAXP = WS_SMALL + 65536;
__device__ __forceinline__ void kmax_item(int item, unsigned char* ws, LAS unsigned char* lds, int tid, int lane, int wave) {
    const int key = item >> 3, part = item & 7, br = key >> 4, bg = key & 15, g = bg & 1, b = bg >> 1;
    const bf16* Kb = (const bf16*)(ws + (br ? WS_KVW : WS_KVS)) + ((size_t)b * SEQ + 512 * part) * 256 + g * 64 + 8 * (lane & 7);
    float mx2 = 0.f;
#pragma unroll
    for (int i = 0; i < 8; ++i) { const int row = 8 * (wave + 8 * i) + (lane >> 3);
        const v4u kq = *(const GAS v4u*)(Kb + (size_t)row * 256);
        float p2 = (bflo(kq.x) * bflo(kq.x) + bfhi(kq.x) * bfhi(kq.x)) + (bflo(kq.y) * bflo(kq.y) + bfhi(kq.y) * bfhi(kq.y)) + (bflo(kq.z) * bflo(kq.z) + bfhi(kq.z) * bfhi(kq.z)) + (bflo(kq.w) * bflo(kq.w) + bfhi(kq.w) * bfhi(kq.w));
        p2 += __shfl_xor(p2, 1); p2 += __shfl_xor(p2, 2); p2 += __shfl_xor(p2, 4);
        mx2 = fmaxf(mx2, p2); }
#pragma unroll
    for (int o = 8; o < 64; o <<= 1) mx2 = fmaxf(mx2, __shfl_xor(mx2, o));
    LAS float* red = (LAS float*)lds;
    if (lane == 0) red[wave] = mx2;
    __syncthreads();
    if (tid == 0) { float m = red[0];
#pragma unroll
        for (int w = 1; w < 8; ++w) m = fmaxf(m, red[w]);
        ((float*)(ws + WS_KMAXP))[item] = m; }
    __syncthreads();
}

__device__ __forceinline__ void nsa_unit(int b, int g, int qb, unsigned char* ws, LAS unsigned char* lds, int tid, int lane, int wave) {
    asm volatile("" : "+v"(tid), "+v"(lane));
    const int r32 = lane & 31, h = lane >> 5, ql = r32 >> 2, hh = r32 & 3;
    const int tl = 8 * wave + ql, t = 64 * qb + tl, hd = g * 4 + hh, bg = b * 2 + g;
    const size_t tok = (size_t)b * SEQ + t;
    bf16x8 qf[4];
#pragma unroll
    for (int ks = 0; ks < 4; ++ks) qf[ks] = ld16g((const bf16*)(ws + WS_QN) + tok * 512 + hd * 64 + 16 * ks + 8 * h);
    float qn = 0.f;
#pragma unroll
    for (int ks = 0; ks < 4; ++ks)
#pragma unroll
        for (int e = 0; e < 8; ++e) { const float v = __builtin_bit_cast(float, ((unsigned)(unsigned short)qf[ks][e]) << 16); qn += v * v; }
    qn += __shfl_xor(qn, 32);
    qn = __builtin_sqrtf(qn) * 1.0001f;
    const float* kmx = (const float*)(ws + WS_KMAXP) + 8 * bg;
    float k2s = kmx[0], k2w = kmx[128];
#pragma unroll
    for (int i = 1; i < 8; ++i) { k2s = fmaxf(k2s, kmx[i]); k2w = fmaxf(k2w, kmx[128 + i]); }
    const float negm_slc = -qn * __builtin_sqrtf(k2s), negm_win = -qn * __builtin_sqrtf(k2w);
    const float negm_cmp = -qn * __builtin_sqrtf(__builtin_bit_cast(float, *(const LAS unsigned*)(lds + KCMAX_OFF)));
    const bf16* NGp = (const bf16*)(ws + WS_NG) + tok * 32 + hd * 3;
    const float g_cmp = bflo((unsigned)NGp[0]), g_slc = bflo((unsigned)NGp[1]), g_win = bflo((unsigned)NGp[2]);
    unsigned outp[2][8];
    unsigned long long selmask = (2ull << qb) - 1ull;
    {
        const int nmaxu = 4 * qb + 2, nlim = t >= 31 ? ((t - 31) >> 4) : -1;
        float l = 0.f, carry = 0.f;
        float xs[8][4];
        f32x16 oc[2], cinit;
#pragma unroll
        for (int r = 0; r < 16; ++r) { oc[0][r] = 0.f; oc[1][r] = 0.f; cinit[r] = negm_cmp; }
#pragma unroll
        for (int mt = 0; mt < 8; ++mt) {
#pragma unroll
            for (int a = 0; a < 4; ++a) xs[mt][a] = 0.f;
            if (32 * mt <= nmaxu) {
                f32x16 a_ = cinit;
#pragma unroll
                for (int ks = 0; ks < 4; ++ks) a_ = mfma32(ld16l(lds + KC_OFF + (32 * mt + r32) * KC_RS + (16 * ks + 8 * h) * 2), qf[ks], a_);
#pragma unroll
                for (int r = 0; r < 16; ++r) { const int nn = 32 * mt + crow(r, h); const float p = nn <= nlim ? fexp2(a_[r]) : 0.f; a_[r] = p; l += p; }
#pragma unroll
                for (int s2 = 0; s2 < 2; ++s2) { const bf16x8 pb = packp(a_, s2);
#pragma unroll
                    for (int md = 0; md < 2; ++md) oc[md] = mfma32(ld16l(lds + VCT_OFF + (32 * md + r32) * VCT_RS + (32 * mt + 16 * s2 + 8 * h) * 2), pb, oc[md]); }
                if (qb >= 16) {
                    float rc[4];
#pragma unroll
                    for (int a = 0; a < 4; ++a) rc[a] = xpartner(a_[4 * a + 3], h);
#pragma unroll
                    for (int a = 0; a < 4; ++a) { const float pv = h ? rc[a] : (a > 0 ? rc[a > 0 ? a - 1 : 0] : carry);
                        xs[mt][a] = ((a_[4 * a] + a_[4 * a + 1]) + (a_[4 * a + 2] + a_[4 * a + 3])) + pv; }
                    carry = rc[3];
                }
            }
        }
        l = xsum(l);
        const float inv = l > 0.f ? 1.f / l : 0.f;
        { const float scl = inv * g_cmp;
#pragma unroll
          for (int r = 0; r < 8; ++r) { outp[0][r] = cvtpk(oc[0][2 * r] * scl, oc[0][2 * r + 1] * scl); outp[1][r] = cvtpk(oc[1][2 * r] * scl, oc[1][2 * r + 1] * scl); } }
        if (qb >= 16) {
            unsigned key[8];
#pragma unroll
            for (int mt = 0; mt < 8; ++mt) {
                float x[4];
#pragma unroll
                for (int a = 0; a < 4; ++a) { x[a] = xs[mt][a] * inv; x[a] += quad_xor1(x[a]); x[a] += quad_xor2(x[a]); }
                const float v = hh == 0 ? x[0] : hh == 1 ? x[1] : hh == 2 ? x[2] : x[3];
                const int J = 8 * mt + 2 * hh + h;
                const bool valid = J <= qb, forced = (J == 0) || (J == qb) || (J == qb - 1);
                const unsigned vb = ((__builtin_bit_cast(unsigned, v) >> 1) | 0x40000000u) & ~63u;
                key[mt] = (!valid ? 0x40u : forced ? 0xC0000000u : vb) | (unsigned)(63 - J);
            }
            selmask = 0ull;
            for (int round = 0; round < 16; ++round) {
                unsigned w = key[0];
#pragma unroll
                for (int i2 = 1; i2 < 8; ++i2) w = w > key[i2] ? w : key[i2];
                unsigned o2 = __builtin_bit_cast(unsigned, quad_xor1(__builtin_bit_cast(float, w))); w = w > o2 ? w : o2;
                o2 = __builtin_bit_cast(unsigned, quad_xor2(__builtin_bit_cast(float, w))); w = w > o2 ? w : o2;
                o2 = (unsigned)__shfl_xor((int)w, 32); w = w > o2 ? w : o2;
                selmask |= 1ull << (63 - (w & 63u));
#pragma unroll
                for (int i2 = 0; i2 < 8; ++i2) key[i2] = key[i2] == w ? 0u : key[i2];
            }
        }
    }
    const bf16* Ksl = (const bf16*)(ws + WS_KVS) + (size_t)b * SEQ * 256 + g * 64;
    const bf16* Kwn = (const bf16*)(ws + WS_KVW) + (size_t)b * SEQ * 256 + g * 64;
    attend<0, true>(outp, qf, negm_slc, Ksl, Ksl + 128, qb, tl, selmask, g_slc, lds, tid, lane, wave);
    attend<1, true>(outp, qf, negm_win, Kwn, Kwn + 128, qb, tl, selmask, g_win, lds, tid, lane, wave);
    bf16* op = (bf16*)(ws + WS_ONSA) + tok * 512 + hd * 64;
#pragma unroll
    for (int md = 0; md < 2; ++md)
#pragma unroll
        for (int a = 0; a < 4; ++a) { v2u ov; ov.x = outp[md][2 * a]; ov.y = outp[md][2 * a + 1];
            *(GAS v2u*)(op + 32 * md + 8 * a + 4 * h) = ov; }
}

#ifndef PHASE_MASK
#define PHASE_MASK 0xffffu
#endif
#ifndef DBL_MASK
#define DBL_MASK 0u
#endif
__global__ void __launch_bounds__(NTHR, 2) mega_fwd(Args args) {
    extern __shared__ __attribute__((aligned(16))) unsigned char lds_raw[];
    LAS unsigned char* lds = (LAS unsigned char*)lds_raw;
    volatile LAS unsigned* MISC = (volatile LAS unsigned*)(lds + MISC_OFF);
    const int tid = threadIdx.x, lane = tid & 63, wave = __builtin_amdgcn_readfirstlane(tid >> 6);
    const int G = gridDim.x; const int vcu = (G % 8 == 0) ? ((int)blockIdx.x % 8) * (G / 8) + (int)blockIdx.x / 8 : (int)blockIdx.x;
    unsigned char* ws = args.ws;
    gu32* ctl = (gu32*)(ws + WS_CTL);
    for (int u = tid; u < (LDS_BYTES - LDSCTL_OFF) / 4; u += NTHR) ((LAS unsigned*)(lds + LDSCTL_OFF))[u] = 0u;
    __syncthreads();
    const int lo = args.ph_lo, hi = args.ph_hi;
    const bool one_launch = (hi - lo) > 1;
    XcdBarrier bar; bar.bar = (unsigned*)(ctl + CW_BAR); bar.x = 0; bar.st = nullptr;
    if (one_launch) bar = xcd_barrier_post((unsigned*)(ctl + CW_BAR), MISC + 8);
#define IN(k) (((PHASE_MASK >> (k)) & 1u) && lo <= (k) && (k) < hi)
#define SEAM(k) do { if (IN(k) && IN((k) + 1)) xcd_barrier(bar); } while (0)
    const int gw = vcu * NWAVES + wave, NGW = G * NWAVES;
    const float* mod = (const float*)(ws + WS_MOD);
    bf16* U = (bf16*)(ws + WS_U); bf16* HACT = (bf16*)(ws + WS_HACT);
    bf16* HS = (bf16*)args.out;

    unsigned long long* SS2 = (unsigned long long*)(ws + WS_SS2); unsigned long long* SS3 = (unsigned long long*)(ws + WS_SS3);
    if (IN(0)) { p0_prologue(args, lds, tid, lane, wave, vcu, G); } SEAM(0);
    if (IN(1)) { cvec_phase(ws, mod, lds, tid, lane, gw, NGW); norm_mod_phase<true>(args.x, args.norm1_w, mod, 0, 1, U, gw, NGW, lane); } SEAM(1);
    if (IN(2)) { pg8::Gemm gm{U, (const bf16*)(ws + WS_W1A), TT, 2 * FF, DM}; pg8::StaticOrder S; S.init(TT, 2 * FF, G, (int)blockIdx.x);
        pg8::EpiSwiglu E{HACT, FF}; pg8::gemm_phase<pg8::EpiSwiglu, pg8::StaticOrder, true, true>(lds, gm, S, E); } SEAM(2);
    if (IN(3)) { pg8::Gemm gm{HACT, (const bf16*)(ws + WS_W1B), TT, DM, FF}; pg8::StaticOrder S; S.init(TT, DM, G, (int)blockIdx.x);
        pg8::EpiResid<true, true> E{args.x, HS, mod + 2 * 1024, U, args.norm2_w, mod + 4 * 1024, SS2, 0.5f}; pg8::gemm_phase<pg8::EpiResid<true, true>, pg8::StaticOrder, true, true>(lds, gm, S, E); } SEAM(3);
    if (IN(4)) { pg8::Gemm gm{U, (const bf16*)(ws + WS_WIN), TT, NPROJ, DM}; pg8::StaticOrder S; S.init(TT, NPROJ, G, (int)blockIdx.x);
        pg8::EpiInProj E{(bf16*)(ws + WS_QN), (bf16*)(ws + WS_KVC), (bf16*)(ws + WS_KVS), (bf16*)(ws + WS_KVW), (bf16*)(ws + WS_RQ), (bf16*)(ws + WS_RK), (bf16*)(ws + WS_RV), (bf16*)(ws + WS_RG),
                         (bf16*)(ws + WS_GA), (bf16*)(ws + WS_GB), (bf16*)(ws + WS_NG), (const float*)(ws + WS_COS), (const float*)(ws + WS_SIN), QSCALE, SS2, (const float*)(ws + WS_CV2)};
        pg8::gemm_phase<pg8::EpiInProj, pg8::StaticOrder, true, true>(lds, gm, S, E); } SEAM(4);
    if (IN(5)) {
        for (int u = vcu; u < 256; u += G) compress_unit(u, ws, lds, lane, wave);
        for (int grp = vcu; grp < 256; grp += G) {
            f32x4 run[2] = {{0.f, 0.f, 0.f, 0.f}, {0.f, 0.f, 0.f, 0.f}};
            ChunkRegs nx = load_chunk(8 * grp, ws, tid);
            for (int i = 0; i < 8; ++i) { const ChunkRegs cr = nx; if (i < 7) nx = load_chunk(8 * grp + i + 1, ws, tid);
                sloc_unit(8 * grp + i, cr, ws, lds, tid, lane, wave, run, i == 7); } }
        for (int it = vcu; it < 256; it += G) kmax_item(it, ws, lds, tid, lane, wave);
    } SEAM(5);
    if (IN(6)) {
        int cur_bg = -1;
        for (int Uu = vcu; Uu < 1024; Uu += G) { const int bg = (Uu & 255) >> 4, sidx = Uu & 15, k = Uu >> 8;
            const int qb = k == 0 ? sidx : k == 1 ? 31 - sidx : k == 2 ? 32 + sidx : 63 - sidx;
            if (bg != cur_bg) { __syncthreads(); load_cmp_images(bg, ws, lds, tid); __syncthreads(); cur_bg = bg; }
            nsa_unit(bg >> 1, bg & 1, qb, ws, lds, tid, lane, wave); }
        __syncthreads();
    }
    if (IN(7)) {
        if (vcu < 2048) { ChunkRegs nx = load_chunk(vcu, ws, tid);
            for (int u = vcu; u < 2048; u += G) { const ChunkRegs cr = nx; if (u + G < 2048) nx = load_chunk(u + G, ws, tid);
                ret_unit(u, cr, ws, args.ret_norm_w, lds, tid, lane, wave); } }
    } SEAM(7);
    if (IN(8)) {
        { pg8::Gemm gm{(const bf16*)(ws + WS_ONSA), (const bf16*)(ws + WS_WNU), TT, DM, 512}; pg8::StaticOrder S; S.init(TT, DM, G, (int)blockIdx.x);
          pg8::EpiMix<false> E{(const bf16*)(ws + WS_GA), (bf16*)(ws + WS_MIXED)}; pg8::gemm_phase<pg8::EpiMix<false>, pg8::StaticOrder, true, true>(lds, gm, S, E); }
        { pg8::Gemm gm{(const bf16*)(ws + WS_ORET), (const bf16*)(ws + WS_WRU), TT, DM, 512}; pg8::StaticOrder S; S.init(TT, DM, G, (int)blockIdx.x);
          pg8::EpiMix<true> E{(const bf16*)(ws + WS_GB), (bf16*)(ws + WS_MIXED)}; pg8::gemm_phase<pg8::EpiMix<true>, pg8::StaticOrder, true, true>(lds, gm, S, E); }
    } SEAM(8);
    if (IN(9)) { pg8::Gemm gm{(const bf16*)(ws + WS_MIXED), (const bf16*)(ws + WS_WO), TT, DM, DM}; pg8::StaticOrder S; S.init(TT, DM, G, (int)blockIdx.x);
        pg8::EpiResid<false, true> E{HS, HS, mod + 5 * 1024, U, args.norm3_w, mod + 7 * 1024, SS3, 1.0f}; pg8::gemm_phase<pg8::EpiResid<false, true>, pg8::StaticOrder, true, true>(lds, gm, S, E); } SEAM(9);
    if (IN(10)) { pg8::Gemm gm{U, (const bf16*)(ws + WS_W2A), TT, 2 * FF, DM}; pg8::StaticOrder S; S.init(TT, 2 * FF, G, (int)blockIdx.x);
        pg8::EpiSwiglu8 E{(unsigned char*)HACT, FF, SS3, (const float*)(ws + WS_CV3)}; pg8::gemm_phase<pg8::EpiSwiglu8, pg8::StaticOrder, true, true>(lds, gm, S, E); } SEAM(10);
    if (IN(11)) { pg8::Gemm gm{HACT, (const bf16*)(ws + WS_W2B), TT, DM, FF / 2};   pg8::StaticOrder S; S.init(TT, DM, G, (int)blockIdx.x);
        pg8::EpiResid<false, false> E{HS, (bf16*)(ws + WS_H3), mod + 8 * 1024, nullptr, nullptr, nullptr, nullptr, 0.5f}; pg8::gemm_phase<pg8::EpiResid<false, false>, pg8::StaticOrder, true, true, true>(lds, gm, S, E); } SEAM(11);
    if (IN(12)) { final_norm_phase((const bf16*)(ws + WS_H3), args.out, args.final_norm_w, gw, NGW, lane); }
#undef IN
#undef SEAM
}

#ifndef N_LAUNCHES
#define N_LAUNCHES 1
#endif
constexpr int N_PHASES = 13;

extern "C" void kernel_launch(void* const* d_in, const int* in_sizes, int n_in, void* d_out, int out_size, void* d_ws, size_t ws_size, hipStream_t stream) {
    static int grid = 0;
    if (grid == 0) {
        if (n_in != 23 || in_sizes[0] != TT * DM || out_size != TT * DM || ws_size < WS_END) { fprintf(stderr, "kernel_launch: unexpected shapes (n_in %d, in0 %d, out %d, ws %zu)\n", n_in, n_in > 0 ? in_sizes[0] : -1, out_size, ws_size); grid = -1; return; }
        int dev = 0, cus = 0, per_cu = 0;
        if (hipGetDevice(&dev) != hipSuccess || hipDeviceGetAttribute(&cus, hipDeviceAttributeMultiprocessorCount, dev) != hipSuccess) { grid = -1; return; }
        if (hipFuncSetAttribute((const void*)mega_fwd, hipFuncAttributeMaxDynamicSharedMemorySize, LDS_BYTES) != hipSuccess) { fprintf(stderr, "kernel_launch: hipFuncSetAttribute failed\n"); grid = -1; return; }
        if (hipOccupancyMaxActiveBlocksPerMultiprocessor(&per_cu, (const void*)mega_fwd, NTHR, LDS_BYTES) != hipSuccess || per_cu < 1) { fprintf(stderr, "kernel_launch: occupancy query reports %d blocks per CU\n", per_cu); (void)hipGetLastError(); per_cu = 1; }
        grid = cus;
    }
    if (grid < 0) return;
    (void)hipMemsetAsync((char*)d_ws + WS_CTL, 0, CTL_ZERO_BYTES, stream);
    Args a{};
    const float** ap = (const float**)&a;
    for (int i = 0; i < 23; ++i) ap[i] = (const float*)d_in[i];
    a.out = (float*)d_out; a.ws = (unsigned char*)d_ws;
    if (N_LAUNCHES == 1) { a.ph_lo = 0; a.ph_hi = N_PHASES; hipLaunchKernelGGL(mega_fwd, dim3(grid), dim3(NTHR), LDS_BYTES, stream, a); }
    else for (int p = 0; p < N_PHASES; ++p) { a.ph_lo = p; a.ph_hi = p + 1; for (int rep = 0; rep < 1 + (int)((DBL_MASK >> p) & 1u); ++rep) hipLaunchKernelGGL(mega_fwd, dim3(grid), dim3(NTHR), LDS_BYTES, stream, a); }
}
```
